# Optimizing an MI355X kernel written in HIP

```python
import jax, jax.numpy as jnp
from jax import lax
import numpy as np

D_MODEL = 1024
BATCH = 8
SEQ = 2048
DEPTH = 2

MEM_LEN = 256
ATT_HEADS = 16
ATT_KV_HEADS = 4
ATT_HEAD_DIM = 64
WINDOW = 128
HG_HEADS = 8
HG_DK = 128
HG_DV = D_MODEL // HG_HEADS
HG_CHUNK = 64
X_HEADS = 4
X_HEAD_DIM = D_MODEL // X_HEADS
N_GROUPS = 4
EXPERTS_PER_GROUP = 8
N_EXPERTS = N_GROUPS * EXPERTS_PER_GROUP
TOP_K = 2
EXPERT_FF = 512
EPS = 1e-6
NEG_BIG = -1e30
F_FLOOR = 1e-30

ATT_Q = ATT_HEADS * ATT_HEAD_DIM
ATT_KV = ATT_KV_HEADS * ATT_HEAD_DIM
HG_K = HG_HEADS * HG_DK
HG_V = HG_HEADS * HG_DV
IN_WIDTHS = (ATT_Q, ATT_KV, ATT_KV, HG_K, HG_K, HG_V, HG_V, D_MODEL, D_MODEL)
P_IN = ATT_Q + 2 * ATT_KV + 2 * HG_K + 2 * HG_V + 2 * D_MODEL

kernel_name = "hybrid_swa_sink_hgrn2_gated_merge_hier_moe"


def rms_norm(x, g):
    xf = x.astype(jnp.float32)
    y = xf * lax.rsqrt(jnp.mean(xf * xf, axis=-1, keepdims=True) + EPS)
    return (y * g.astype(jnp.float32)).astype(x.dtype)


def sliding_window_attention(q, k, v, sinks):
    B, S = q.shape[0], q.shape[1]
    nb = S // WINDOW
    G = ATT_HEADS // ATT_KV_HEADS
    f32 = jnp.float32
    qb = q.reshape(B, nb, WINDOW, ATT_KV_HEADS, G, ATT_HEAD_DIM).astype(f32)
    kb = k.reshape(B, nb, WINDOW, ATT_KV_HEADS, ATT_HEAD_DIM).astype(f32)
    vb = v.reshape(B, nb, WINDOW, ATT_KV_HEADS, ATT_HEAD_DIM).astype(f32)

    def with_prev(t):
        prev = jnp.pad(t[:, :-1], ((0, 0), (1, 0), (0, 0), (0, 0), (0, 0)))
        return jnp.concatenate([prev, t], axis=2)

    kk, vv = with_prev(kb), with_prev(vb)
    s = jnp.einsum('bnqhgd,bnshd->bnhgqs', qb, kk) * (ATT_HEAD_DIM ** -0.5)
    qi = jnp.arange(WINDOW)[:, None]
    kj = jnp.arange(2 * WINDOW)[None, :]
    dist = qi + WINDOW - kj
    blk = jnp.arange(nb)[:, None, None]
    valid = (dist >= 0) & (dist < WINDOW) & ((blk > 0) | (kj >= WINDOW))
    s = jnp.where(valid[None, :, None, None], s, NEG_BIG)
    sink = sinks.astype(f32).reshape(ATT_KV_HEADS, G)[None, None, :, :, None, None]
    m = jnp.maximum(jnp.max(s, axis=-1, keepdims=True), sink)
    p = jnp.where(valid[None, :, None, None], jnp.exp(s - m), 0.0)
    denom = jnp.sum(p, axis=-1, keepdims=True) + jnp.exp(sink - m)
    o = jnp.einsum('bnhgqs,bnshd->bnqhgd', p / denom, vv)
    return o.reshape(B, S, ATT_Q)


def hgrn2_chunkwise(q, k, logf, v):
    B, S = q.shape[0], q.shape[1]
    nc = S // HG_CHUNK

    def to_chunks(t):
        return t.reshape(B, nc, HG_CHUNK, HG_HEADS, t.shape[-1]).transpose(1, 0, 3, 2, 4)

    causal = jnp.tril(jnp.ones((HG_CHUNK, HG_CHUNK), dtype=bool))

    def step(state, xs):
        qc, kc, gc, vc = xs
        b = jnp.cumsum(gc, axis=2)
        o_inter = jnp.einsum('bhtk,bhkv->bhtv', qc * jnp.exp(b), state)
        diff = b[:, :, :, None, :] - b[:, :, None, :, :]
        decay = jnp.where(causal[:, :, None], jnp.exp(jnp.minimum(diff, 0.0)), 0.0)
        a = jnp.einsum('bhtk,bhtsk,bhsk->bhts', qc, decay, kc)
        o_intra = jnp.einsum('bhts,bhsv->bhtv', a, vc)
        b_last = b[:, :, -1:, :]
        new_state = (jnp.exp(b_last[:, :, 0, :])[..., None] * state
                     + jnp.einsum('bhsk,bhsv->bhkv', kc * jnp.exp(jnp.minimum(b_last - b, 0.0)), vc))
        return new_state, o_inter + o_intra

    s0 = jnp.zeros((B, HG_HEADS, HG_DK, HG_DV), jnp.float32)
    _, o = lax.scan(step, s0, (to_chunks(q), to_chunks(k), to_chunks(logf), to_chunks(v)))
    return o.transpose(1, 0, 3, 2, 4).reshape(B, S, HG_HEADS, HG_DV)


def cross_attention(h, memn, w_q, w_kv, w_o):
    B, S = h.shape[0], h.shape[1]
    q = (h @ w_q).reshape(B, S, X_HEADS, X_HEAD_DIM)
    k, v = jnp.split(memn @ w_kv, 2, axis=-1)
    k = k.reshape(B, -1, X_HEADS, X_HEAD_DIM)
    v = v.reshape(B, -1, X_HEADS, X_HEAD_DIM)
    s = jnp.einsum('bqhd,bmhd->bhqm', q, k).astype(jnp.float32) * (X_HEAD_DIM ** -0.5)
    p = jax.nn.softmax(s, axis=-1)
    o = jnp.einsum('bhqm,bmhd->bqhd', p, v.astype(jnp.float32)).reshape(B, S, D_MODEL)
    return o.astype(h.dtype) @ w_o


def hierarchical_moe(h, w_router, b_router, w_gate_up, w_down):
    B, S, D = h.shape
    t = h.reshape(B * S, D)
    logits = (t @ w_router + b_router).astype(jnp.float32)
    g_prob = jax.nn.softmax(logits[:, :N_GROUPS], axis=-1)
    e_logits = logits[:, N_GROUPS:].reshape(-1, N_GROUPS, EXPERTS_PER_GROUP)
    g_top, g_idx = lax.top_k(g_prob, 1)
    e_in = jnp.take_along_axis(e_logits, g_idx[:, :, None], axis=1)[:, 0]
    e_top, e_idx = lax.top_k(e_in, TOP_K)
    e_w = jax.nn.softmax(e_top, axis=-1) * g_top
    eid = g_idx * EXPERTS_PER_GROUP + e_idx
    combine = jnp.sum(jax.nn.one_hot(eid, N_EXPERTS, dtype=jnp.float32) * e_w[..., None], axis=1)
    out = jnp.zeros((B * S, D), jnp.float32)
    for e in range(N_EXPERTS):
        gate, up = jnp.split(t @ w_gate_up[e], 2, axis=-1)
        y = (jax.nn.silu(gate) * up) @ w_down[e]
        out = out + combine[:, e:e + 1] * y.astype(jnp.float32)
    return out.astype(h.dtype).reshape(B, S, D)


def setup_inputs(seed: int = 0) -> dict:
    key = jax.random.key(seed)
    ks = jax.random.split(key, 20)
    n = jax.random.normal
    D = D_MODEL
    return {
        "x": n(ks[0], (BATCH, SEQ, D), jnp.float32),
        "mem": n(ks[1], (BATCH, MEM_LEN, D), jnp.float32),
        "mix_norm": 1.0 + 0.05 * n(ks[2], (DEPTH, D), jnp.float32),
        "w_in": n(ks[3], (DEPTH, D, P_IN), jnp.float32) * D ** -0.5,
        "b_in": 0.02 * n(ks[4], (DEPTH, P_IN), jnp.float32),
        "attn_sinks": 0.5 * n(ks[5], (DEPTH, ATT_HEADS), jnp.float32),
        "hg_lb_logits": 0.5 * n(ks[6], (DEPTH, HG_K), jnp.float32),
        "hg_out_norm": 1.0 + 0.05 * n(ks[7], (DEPTH, HG_DV), jnp.float32),
        "w_out": n(ks[8], (DEPTH, D, D), jnp.float32) * D ** -0.5,
        "cross_norm": 1.0 + 0.05 * n(ks[9], (DEPTH, D), jnp.float32),
        "mem_norm": 1.0 + 0.05 * n(ks[10], (D,), jnp.float32),
        "w_cq": n(ks[11], (DEPTH, D, D), jnp.float32) * D ** -0.5,
        "w_ckv": n(ks[12], (DEPTH, D, 2 * D), jnp.float32) * D ** -0.5,
        "w_co": n(ks[13], (DEPTH, D, D), jnp.float32) * D ** -0.5,
        "ffn_norm": 1.0 + 0.05 * n(ks[14], (DEPTH, D), jnp.float32),
        "w_router": n(ks[15], (DEPTH, D, N_GROUPS + N_EXPERTS), jnp.float32) * D ** -0.5,
        "b_router": 0.01 * n(ks[16], (DEPTH, N_GROUPS + N_EXPERTS), jnp.float32),
        "w_gate_up": n(ks[17], (DEPTH, N_EXPERTS, D, 2 * EXPERT_FF), jnp.float32) * D ** -0.5,
        "w_down": n(ks[18], (DEPTH, N_EXPERTS, EXPERT_FF, D), jnp.float32) * EXPERT_FF ** -0.5,
        "final_norm": 1.0 + 0.05 * n(ks[19], (D,), jnp.float32),
    }


def reference(x, mem, mix_norm, w_in, b_in, attn_sinks, hg_lb_logits, hg_out_norm, w_out,
              cross_norm, mem_norm, w_cq, w_ckv, w_co, ffn_norm, w_router, b_router,
              w_gate_up, w_down, final_norm):
    B, S = x.shape[0], x.shape[1]
    f32 = jnp.float32
    offs = [sum(IN_WIDTHS[:i + 1]) for i in range(len(IN_WIDTHS) - 1)]
    lb_soft = jax.nn.softmax(hg_lb_logits.astype(f32), axis=0)
    lb_all = jnp.cumsum(lb_soft, axis=0) - lb_soft[0]
    memn = rms_norm(mem, mem_norm)

    for l in range(DEPTH):
        h = rms_norm(x, mix_norm[l])
        proj = h @ w_in[l] + b_in[l]
        q_a, k_a, v_a, q_h, f_h, i_h, og_h, g_a, g_h = jnp.split(proj, offs, axis=-1)

        att = sliding_window_attention(
            q_a.reshape(B, S, ATT_HEADS, ATT_HEAD_DIM),
            k_a.reshape(B, S, ATT_KV_HEADS, ATT_HEAD_DIM),
            v_a.reshape(B, S, ATT_KV_HEADS, ATT_HEAD_DIM),
            attn_sinks[l])

        lb = lb_all[l].reshape(HG_HEADS, HG_DK)
        fpre = f_h.astype(f32).reshape(B, S, HG_HEADS, HG_DK)
        f_gate = lb + (1.0 - lb) * jax.nn.sigmoid(fpre)
        logf = jnp.log(jnp.maximum(f_gate, F_FLOOR))
        k_h = (1.0 - lb) * jax.nn.sigmoid(-fpre)
        qh = jax.nn.silu(q_h.astype(f32)).reshape(B, S, HG_HEADS, HG_DK)
        vh = i_h.astype(f32).reshape(B, S, HG_HEADS, HG_DV)
        o_h = hgrn2_chunkwise(qh, k_h, logf, vh)
        hg = rms_norm(o_h, hg_out_norm[l]).reshape(B, S, HG_V) * jax.nn.silu(og_h.astype(f32))

        mix = (jax.nn.sigmoid(g_a.astype(f32)) * att + jax.nn.sigmoid(g_h.astype(f32)) * hg).astype(x.dtype)
        x = x + mix @ w_out[l]

        x = x + cross_attention(rms_norm(x, cross_norm[l]), memn, w_cq[l], w_ckv[l], w_co[l])

        x = x + hierarchical_moe(rms_norm(x, ffn_norm[l]), w_router[l], b_router[l], w_gate_up[l], w_down[l])

    return rms_norm(x, final_norm)
```

```cpp
#include <hip/hip_runtime.h>
#include <cstdio>
#include <cstdint>

#define DBG_EMIT 4
#define DBG_PROBE_OFF ((size_t)700 * 1024 * 1024)
#define DBG_BUF OFF_GA
#ifndef FAST_HGRN
#define FAST_HGRN 1
#endif
#ifndef FAST_SWA
#define FAST_SWA 1
#endif
#ifndef FAST_XATTN
#define FAST_XATTN 1
#endif
#ifndef ONE_LAUNCH
#define ONE_LAUNCH 1
#endif

#define DEV __device__ __forceinline__

typedef unsigned short bf16_t;
typedef short bf16x8 __attribute__((ext_vector_type(8)));
typedef float f32x4 __attribute__((ext_vector_type(4)));
typedef unsigned u32x4 __attribute__((ext_vector_type(4)));
typedef unsigned u32x2 __attribute__((ext_vector_type(2)));
typedef float f32x16 __attribute__((ext_vector_type(16)));

constexpr int D = 1024, NB = 8, SEQ = 2048, T = NB * SEQ, MEM = 256, TMEM = NB * MEM;
constexpr int PIN = 7680, NEXP = 32, EFF = 512, NRL = 36;
constexpr float EPS = 1e-6f;

constexpr size_t MB = 1024 * 1024;
constexpr size_t OFF_CTL = 0;
constexpr size_t CTL_BYTES = 32768;
constexpr size_t OFF_CNT = 16384;
constexpr size_t OFF_LBT = CTL_BYTES;
constexpr size_t OFF_W = 1 * MB;
constexpr size_t W_IN = 0, W_OUT = W_IN + (size_t)PIN * D * 2, W_CQ = W_OUT + (size_t)2 * D * D * 2  , W_CKV = W_CQ + (size_t)D * D * 2,
                 W_CO = W_CKV + (size_t)2 * D * D * 2, W_R = W_CO + (size_t)D * D * 2, W_GU = W_R + (size_t)128 * D * 2,
                 W_DN = W_GU + (size_t)NEXP * D * D * 2, W_LAYER = W_DN + (size_t)NEXP * D * EFF * 2;
constexpr size_t OFF_MEMN = OFF_W + 2 * W_LAYER;
constexpr size_t OFF_KC = OFF_MEMN + (size_t)TMEM * D * 2;
constexpr size_t OFF_VCT = OFF_KC + 2 * (size_t)TMEM * D * 2;
constexpr size_t OFF_HB = OFF_VCT + 2 * (size_t)TMEM * D * 2;
constexpr size_t OFF_X = OFF_HB + (size_t)T * D * 2;
constexpr size_t SZ_B = (size_t)T * D * 2;
constexpr size_t OFF_QA = OFF_X + (size_t)T * D * 4;
constexpr size_t OFF_KA = OFF_QA + SZ_B;
constexpr size_t OFF_VAT = OFF_KA + SZ_B / 4;
constexpr size_t OFF_QH = OFF_VAT + SZ_B / 4;
constexpr size_t OFF_LOGF = OFF_QH + SZ_B;
constexpr size_t OFF_KH = OFF_LOGF + 2 * SZ_B;
constexpr size_t OFF_VHT = OFF_KH + SZ_B;
constexpr size_t OFF_OG = OFF_VHT + SZ_B;
constexpr size_t OFF_GA = OFF_OG + SZ_B;
constexpr size_t OFF_GH = OFF_GA + SZ_B;
constexpr size_t OFF_Q1 = OFF_GH + SZ_B;
constexpr size_t OFF_K2T = OFF_Q1 + SZ_B;
constexpr size_t OFF_AM = OFF_K2T + SZ_B;
constexpr size_t OFF_DD = OFF_AM + SZ_B / 4;
constexpr size_t OFF_MIXA = OFF_DD + 2 * MB;
constexpr size_t OFF_MIXH = OFF_MIXA + SZ_B;
constexpr size_t OFF_EW = OFF_MIXH + SZ_B;
constexpr size_t OFF_LIST = OFF_EW + (size_t)T * 2 * 4;
constexpr size_t OFF_RSQ = OFF_LIST + (size_t)NEXP * T * 4;
constexpr size_t OFF_SRL = OFF_RSQ + (size_t)4 * T * 16 * 4;
constexpr size_t OFF_EWL = OFF_SRL + (size_t)NEXP * T * 4;
constexpr size_t OFF_RSTD = OFF_EWL + (size_t)NEXP * T * 4;
constexpr size_t OFF_END = OFF_RSTD + (size_t)T * 4;
constexpr size_t OFF_QC = OFF_QH, OFF_OC = OFF_KH, OFF_ACT = OFF_LOGF, OFF_YB = OFF_OG;

struct Params {
    const float *x, *mem, *mix_norm, *w_in, *b_in, *attn_sinks, *hg_lb_logits, *hg_out_norm, *w_out, *cross_norm, *mem_norm,
                *w_cq, *w_ckv, *w_co, *ffn_norm, *w_router, *b_router, *w_gate_up, *w_down, *final_norm;
    float* out;
    unsigned char* ws;
};

typedef __bf16 bf16x2_t __attribute__((ext_vector_type(2)));
DEV unsigned pk2(float lo, float hi) { bf16x2_t v = {(__bf16)lo, (__bf16)hi}; return __builtin_bit_cast(unsigned, v); }
DEV bf16_t f2bf(float x) { return __builtin_bit_cast(unsigned short, (__bf16)x); }
DEV bf16x8 pack8(const f32x16& x, int s) {
    u32x4 w; w.x = pk2(x[8 * s + 0], x[8 * s + 1]); w.y = pk2(x[8 * s + 2], x[8 * s + 3]); w.z = pk2(x[8 * s + 4], x[8 * s + 5]); w.w = pk2(x[8 * s + 6], x[8 * s + 7]);
    return __builtin_bit_cast(bf16x8, w);
}
DEV float bf2f(bf16_t h) { return __uint_as_float((unsigned)h << 16); }
DEV float bflo(unsigned u) { return __uint_as_float(u << 16); }
DEV float bfhi(unsigned u) { return __uint_as_float(u & 0xffff0000u); }
DEV float fexp(float x) { return __builtin_amdgcn_exp2f(x * 1.44269504089f); }
DEV float flog(float x) { return __builtin_amdgcn_logf(x) * 0.69314718056f; }
DEV float frcp(float x) { return __builtin_amdgcn_rcpf(x); }
DEV float fsigmoid(float x) { return frcp(1.0f + fexp(-x)); }
DEV float fsilu(float x) { return x * fsigmoid(x); }
DEV int perm16(int i) { return ((i >> 2) & 1) * 8 + ((i >> 3) & 1) * 4 + (i & 3); }
DEV int otid() { int t = threadIdx.x & 255; asm volatile("" : "+v"(t)); return t; }
DEV int otid512() { int t = threadIdx.x; asm volatile("" : "+v"(t)); return t; }
DEV float ld_rsq(const float* p) {
    const f32x4 a = *(const f32x4*)p, b = *(const f32x4*)(p + 4), c = *(const f32x4*)(p + 8), d = *(const f32x4*)(p + 12);
    return ((a[0] + a[1]) + (a[2] + a[3])) + ((b[0] + b[1]) + (b[2] + b[3])) + (((c[0] + c[1]) + (c[2] + c[3])) + ((d[0] + d[1]) + (d[2] + d[3])));
}
DEV float wave_sum(float v) {
    v += __shfl_xor(v, 32); v += __shfl_xor(v, 16); v += __shfl_xor(v, 8); v += __shfl_xor(v, 4); v += __shfl_xor(v, 2); v += __shfl_xor(v, 1); return v;
}
DEV float wave_max(float v) {
    v = fmaxf(v, __shfl_xor(v, 32)); v = fmaxf(v, __shfl_xor(v, 16)); v = fmaxf(v, __shfl_xor(v, 8)); v = fmaxf(v, __shfl_xor(v, 4)); v = fmaxf(v, __shfl_xor(v, 2)); v = fmaxf(v, __shfl_xor(v, 1)); return v;
}

#define XB_TMO      128
#define XB_XCNT(j)  (256  + 64 * (j))
#define XB_XSUB(j)  (1280 + 64 * (j))
#define XB_XGEN(j)  (2304 + 64 * (j))
#define XB_TOP      3328
#define XB_TOPGEN   3392
#define XCD_BAR_WORDS 3456
#define XB_SPIN_CAP (1u << 18)
#define LAS __attribute__((address_space(3)))

__device__ __forceinline__ unsigned xb_ld(unsigned* p)              { return __hip_atomic_load(p, __ATOMIC_RELAXED, __HIP_MEMORY_SCOPE_AGENT); }
__device__ __forceinline__ unsigned xb_add(unsigned* p, unsigned v) { return __hip_atomic_fetch_add(p, v, __ATOMIC_RELAXED, __HIP_MEMORY_SCOPE_AGENT); }
__device__ __forceinline__ unsigned xb_xcc_id() { return (unsigned)__builtin_amdgcn_s_getreg((3 << 11) | 20) & 0xFu; }
#define XB_SPIN(cond, bar) do { unsigned _sp = 0; while (cond) { __builtin_amdgcn_s_sleep(1); \
    if ((++_sp & 255u) == 0u) { if (xb_ld(&(bar)[XB_TMO])) break; if (_sp > XB_SPIN_CAP) { atomicAdd(&(bar)[XB_TMO], 1u); break; } } } } while (0)

extern __shared__ __attribute__((aligned(16))) unsigned char smem_all[];
struct XcdBarrier { unsigned* bar; unsigned x; unsigned nloc, nx; };

__device__ __forceinline__ XcdBarrier xcd_barrier_post(unsigned* bar) {
    XcdBarrier b; b.bar = bar; b.x = xb_xcc_id(); b.nloc = 0u; b.nx = 0u;
    if (threadIdx.x == 0) { (void)xb_add(&bar[XB_XCNT(b.x)], 1u); volatile unsigned* cen = (volatile unsigned*)(smem_all + 131072 + 3072); cen[0] = 0u; cen[1] = 0u; }
    return b;
}
__device__ __forceinline__ void xcd_barrier_complete(unsigned* bar, unsigned x, unsigned& nloc, unsigned& nx) {
    const unsigned G = gridDim.x * gridDim.y * gridDim.z;
    unsigned sum, cnt, mine, sp = 0u;
    for (;;) {
        sum = 0u; cnt = 0u; mine = 0u;
#pragma unroll
        for (unsigned j = 0; j < 16; ++j) { const unsigned c = xb_ld(&bar[XB_XCNT(j)]); sum += c; cnt += (c > 0u) ? 1u : 0u; mine = (j == x) ? c : mine; }
        if (sum == G) break;
        __builtin_amdgcn_s_sleep(1);
        if ((++sp & 255u) == 0u) { if (xb_ld(&bar[XB_TMO])) break; if (sp > XB_SPIN_CAP) { atomicAdd(&bar[XB_TMO], 1u); break; } }
    }
    nloc = mine > 0u ? mine : 1u; nx = cnt > 0u ? cnt : 1u;
}
__device__ __forceinline__ void xcd_barrier(XcdBarrier& b) {
    asm volatile("s_waitcnt vmcnt(0)" ::: "memory");
    __syncthreads();
    if (threadIdx.x == 0) {
        unsigned* bar = b.bar;
        __builtin_amdgcn_s_waitcnt(0);
        volatile unsigned* cen = (volatile unsigned*)(smem_all + 131072 + 3072);
        unsigned nloc = cen[0], nx = cen[1];
        if (nloc == 0u) { xcd_barrier_complete(bar, b.x, nloc, nx); cen[0] = nloc; cen[1] = nx; }
        const unsigned old = xb_add(&bar[XB_XSUB(b.x)], 1u);
        const unsigned gen = old / nloc;
        if (old + 1u == (gen + 1u) * nloc) {
            __builtin_amdgcn_fence(__ATOMIC_RELEASE, "agent");
            asm volatile("s_waitcnt vmcnt(0)" ::: "memory");
            const unsigned og = xb_add(&bar[XB_TOP], 1u);
            const unsigned tg = og / nx;
            if (og + 1u == (tg + 1u) * nx) xb_add(&bar[XB_TOPGEN], 1u);
            else XB_SPIN(xb_ld(&bar[XB_TOPGEN]) == tg, bar);
            __builtin_amdgcn_fence(__ATOMIC_ACQUIRE, "agent");
            xb_add(&bar[XB_XGEN(b.x)], 1u);
            asm volatile("s_waitcnt vmcnt(0)" ::: "memory");
        } else {
            XB_SPIN(xb_ld(&bar[XB_XGEN(b.x)]) == gen, bar);
            __builtin_amdgcn_fence(__ATOMIC_ACQUIRE, "agent");
            asm volatile("s_waitcnt vmcnt(0)" ::: "memory");
        }
    }
    __syncthreads();
}

constexpr int LDS_BYTES = 131072 + 4096;
constexpr int LDS_MOE = 131072;
extern __shared__ __attribute__((aligned(16))) unsigned char smem_all[];
#define smem (smem_all + ((threadIdx.x >> 8) << 16))
DEV int vhalf() { return __builtin_amdgcn_readfirstlane((int)(threadIdx.x >> 8)); }
DEV int vbid() { return (int)blockIdx.x * 2 + vhalf(); }
DEV int vgrid() { return (int)gridDim.x * 2; }

DEV int gu_perm(int n) { return n < 512 ? ((n >> 4) * 32 + (n & 15)) : (((n - 512) >> 4) * 32 + 16 + ((n - 512) & 15)); }

DEV int win_perm(int n) {
    if (n >= 4608 && n < 5632) { const int hd = (n - 4608) >> 7, c = (n - 4608) & 127; return (hd < 4 ? 4608 + 256 * hd : 6656 + 256 * (hd - 4)) + c; }
    if (n >= 6656) { const int hd = (n - 6656) >> 7, c = (n - 6656) & 127; return (hd < 4 ? 4608 + 256 * hd : 6656 + 256 * (hd - 4)) + 128 + c; }
    return n;
}
struct ConvTile { const float* src; bf16_t* dst; int K, N, k0, n0; bool perm; const float* gk; int ldd; bool dup; bool wperm; };
DEV void conv_load(const ConvTile& c, float4 (&v)[8], int tid) {
#pragma unroll
    for (int j = 0; j < 8; ++j) { const f32x4 t = __builtin_nontemporal_load((const f32x4*)(c.src + (size_t)(c.k0 + 8 * (tid >> 4) + j) * c.N + c.n0 + 4 * (tid & 15)));
        v[j] = make_float4(t[0], t[1], t[2], t[3]); }
}
DEV void conv_pack(const ConvTile& c, const float4 (&v)[8], u32x4 (&w)[4], int tid) {
    const int kk = c.k0 + 8 * (tid >> 4);
    float g8[8];
#pragma unroll
    for (int j = 0; j < 8; ++j) g8[j] = c.gk ? c.gk[kk + j] : 1.0f;
#pragma unroll
    for (int i = 0; i < 4; ++i) {
        w[i].x = pk2((i == 0 ? v[0].x : i == 1 ? v[0].y : i == 2 ? v[0].z : v[0].w) * g8[0], (i == 0 ? v[1].x : i == 1 ? v[1].y : i == 2 ? v[1].z : v[1].w) * g8[1]);
        w[i].y = pk2((i == 0 ? v[2].x : i == 1 ? v[2].y : i == 2 ? v[2].z : v[2].w) * g8[2], (i == 0 ? v[3].x : i == 1 ? v[3].y : i == 2 ? v[3].z : v[3].w) * g8[3]);
        w[i].z = pk2((i == 0 ? v[4].x : i == 1 ? v[4].y : i == 2 ? v[4].z : v[4].w) * g8[4], (i == 0 ? v[5].x : i == 1 ? v[5].y : i == 2 ? v[5].z : v[5].w) * g8[5]);
        w[i].w = pk2((i == 0 ? v[6].x : i == 1 ? v[6].y : i == 2 ? v[6].z : v[6].w) * g8[6], (i == 0 ? v[7].x : i == 1 ? v[7].y : i == 2 ? v[7].z : v[7].w) * g8[7]);
    }
}
DEV void conv_store(const ConvTile& c, const u32x4 (&w)[4], int tid) {
    const int kk = c.k0 + 8 * (tid >> 4);
#pragma unroll
    for (int i = 0; i < 4; ++i) {
        const int n = c.n0 + 4 * (tid & 15) + i, drow = c.perm ? gu_perm(n) : (c.wperm ? win_perm(n) : n);
        *(u32x4*)(c.dst + (size_t)drow * c.ldd + kk) = w[i];
        if (c.dup) *(u32x4*)(c.dst + (size_t)drow * c.ldd + c.K + kk) = w[i];
    }
}

DEV void rownorm_to_bf16(const float* __restrict__ src, const float* __restrict__ g, bf16_t* __restrict__ dst, int lane, bf16_t* __restrict__ raw = nullptr) {
    float4 v[4]; float ss = 0.f;
#pragma unroll
    for (int i = 0; i < 4; ++i) { v[i] = *(const float4*)(src + 4 * lane + 256 * i); ss += v[i].x * v[i].x + v[i].y * v[i].y + v[i].z * v[i].z + v[i].w * v[i].w; }
    ss = wave_sum(ss);
    const float rstd = rsqrtf(ss * (1.0f / D) + EPS);
#pragma unroll
    for (int i = 0; i < 4; ++i) {
        const float4 gg = *(const float4*)(g + 4 * lane + 256 * i);
        u32x2 o; o.x = pk2(v[i].x * rstd * gg.x, v[i].y * rstd * gg.y); o.y = pk2(v[i].z * rstd * gg.z, v[i].w * rstd * gg.w);
        *(u32x2*)(dst + 4 * lane + 256 * i) = o;
        if (raw) { u32x2 q; q.x = pk2(v[i].x, v[i].y); q.y = pk2(v[i].z, v[i].w); *(u32x2*)(raw + 4 * lane + 256 * i) = q; }
    }
}

DEV ConvTile conv_describe(const Params& p, int l, int t) {
    constexpr int J0 = 960, J1 = J0 + 128, J2 = J1 + 128, J3 = J2 + 256, J4 = J3 + 128, J5 = J4 + 4096;
    unsigned char* wl = p.ws + OFF_W + (size_t)l * W_LAYER;
    ConvTile c; c.perm = false; c.gk = nullptr; c.dup = false; c.wperm = false; int ti;
#define CB asm volatile("" ::: "memory");
    if (t < J0) { CB c.src = p.w_in + (size_t)l * D * PIN; c.dst = (bf16_t*)(wl + W_IN); c.K = D; c.N = PIN; ti = t; c.wperm = true; c.gk = p.mix_norm + l * D; }
    else if (t < J1) { CB c.src = p.w_out + (size_t)l * D * D; c.dst = (bf16_t*)(wl + W_OUT); c.K = D; c.N = D; ti = t - J0; }
    else if (t < J2) { CB c.src = p.w_cq + (size_t)l * D * D; c.dst = (bf16_t*)(wl + W_CQ); c.K = D; c.N = D; ti = t - J1; c.gk = p.cross_norm + l * D; }
    else if (t < J3) { CB c.src = p.w_ckv + (size_t)l * D * 2 * D; c.dst = (bf16_t*)(wl + W_CKV); c.K = D; c.N = 2 * D; ti = t - J2; }
    else if (t < J4) { CB c.src = p.w_co + (size_t)l * D * D; c.dst = (bf16_t*)(wl + W_CO); c.K = D; c.N = D; ti = t - J3; }
    else if (t < J5) { CB const int e = (t - J4) >> 7; c.src = p.w_gate_up + ((size_t)l * NEXP + e) * D * D; c.dst = (bf16_t*)(wl + W_GU) + (size_t)e * D * D; c.K = D; c.N = D; c.perm = true; ti = (t - J4) & 127; c.gk = p.ffn_norm + l * D; }
    else { CB const int e = (t - J5) >> 6; c.src = p.w_down + ((size_t)l * NEXP + e) * EFF * D; c.dst = (bf16_t*)(wl + W_DN) + (size_t)e * D * EFF; c.K = EFF; c.N = D; ti = (t - J5) & 63; }
#undef CB
    const int tn = c.N >> 6; c.k0 = (ti / tn) * 128; c.n0 = (ti % tn) * 64; c.ldd = c.dup ? 2 * c.K : c.K;
    return c;
}
DEV int conv_pick(int sel, int idx) { return sel == 0 ? (idx < 960 ? idx : idx + 256) : (idx < 256 ? 960 + idx : idx + 1216); }
DEV void conv_range(const Params& p, int l, int sel, int t0, int t1, int b0, int nb) {
    const int n = t1 - t0, rounds = (n + nb - 1) / nb;
    if (n <= 0) return;
    const int tid = otid();
    auto tix = [&](int k) { if (k >= rounds) k = rounds - 1; int t = b0 + k * nb; return conv_pick(sel, t0 + (t < n ? t : n - 1)); };
    ConvTile ca = conv_describe(p, l, tix(0)), cb = conv_describe(p, l, tix(1)); float4 va[8]; u32x4 wa[4];
    conv_load(ca, va, tid);
    for (int k = 0; k < rounds; k += 2) {
        conv_pack(ca, va, wa, tid);
        cb = conv_describe(p, l, tix(k + 1)); conv_load(cb, va, tid);
        conv_store(ca, wa, tid);
        if (k + 1 < rounds) {
            conv_pack(cb, va, wa, tid);
            ca = conv_describe(p, l, tix(k + 2)); conv_load(ca, va, tid);
            conv_store(cb, wa, tid);
        }
    }
}
DEV void conv_layer(const Params& p, int l, int sel, int b0, int nb) { conv_range(p, l, sel, 0, sel == 0 ? 1216 : 6528, b0, nb); }
constexpr int CV_N1 = 6528, CV_INPROJ = 576, CV_DOWN = 700;
DEV int conv_mix_end(int l) { return (int)gridDim.x == 256 ? CV_N1 - CV_INPROJ - (l == 1 ? CV_DOWN : 0) : CV_N1; }
DEV void conv_in_moe_tail(const Params& p, int l, int sel, int t0, int t1) {
    const int NU = 4 * __builtin_amdgcn_readfirstlane(*(const int*)(smem_all + LDS_MOE + 160 * 16)), G = (int)gridDim.x, c = (int)blockIdx.x;
    const int R = (NU + G - 1) / G, nfull = NU > 0 ? NU - (R - 1) * G : 0, idle = G - nfull;
    if (idle >= 32) { if (c >= nfull) conv_range(p, l, sel, t0, t1, 2 * (c - nfull) + vhalf(), 2 * idle); }
    else conv_range(p, l, sel, t0, t1, vbid(), vgrid());
}
DEV void phase_conv(const Params& p) {
    const int G = vgrid(), bid = vbid(), tid = threadIdx.x & 255;
    unsigned char* ws = p.ws;
    conv_layer(p, 0, 0, bid, G);
    for (int idx = bid * 256 + tid; idx < 2 * 128 * D; idx += G * 256) {
        const int l = idx / (128 * D), r = idx % (128 * D), n = r / D, k = r % D;
        const float v = n < NRL ? p.w_router[(size_t)l * D * NRL + (size_t)k * NRL + n] * p.ffn_norm[l * D + k] : 0.f;
        ((bf16_t*)(ws + OFF_W + (size_t)l * W_LAYER + W_R))[r] = f2bf(v);
    }
    if (bid == 0 && tid < 128) ((unsigned*)(ws + OFF_CNT))[tid] = 0u;
    for (int idx = bid * 256 + tid; idx < D; idx += G * 256) {
        float* lbt = (float*)(ws + OFF_LBT);
        const float l0 = p.hg_lb_logits[idx], l1 = p.hg_lb_logits[D + idx];
        lbt[idx] = 0.f; lbt[D + idx] = 1.0f / (1.0f + expf(l0 - l1));
    }
    const int lane = tid & 63, gw = bid * 4 + (tid >> 6), nw = G * 4;
    for (int r = gw; r < TMEM + T; r += nw) {
        if (r < TMEM) rownorm_to_bf16(p.mem + (size_t)r * D, p.mem_norm, (bf16_t*)(ws + OFF_MEMN) + (size_t)r * D, lane);
        else {
            const int t = r - TMEM; const float* src = p.x + (size_t)t * D; bf16_t* raw = (bf16_t*)(ws + OFF_X) + (size_t)t * D;
            float4 v[4]; float ss = 0.f;
#pragma unroll
            for (int i = 0; i < 4; ++i) { v[i] = *(const float4*)(src + 4 * lane + 256 * i); ss += v[i].x * v[i].x + v[i].y * v[i].y + v[i].z * v[i].z + v[i].w * v[i].w; }
            ss = wave_sum(ss);
#pragma unroll
            for (int i = 0; i < 4; ++i) { u32x2 q; q.x = pk2(v[i].x, v[i].y); q.y = pk2(v[i].z, v[i].w); *(u32x2*)(raw + 4 * lane + 256 * i) = q; }
            if (lane == 0) ((float*)(ws + OFF_RSTD))[t] = rsqrtf(ss * (1.0f / D) + EPS);
        }
    }
}

struct ARows {
    const bf16_t* A; int lda;
    const int* list;
    int nvalid;
    int rowoff;
    const bf16_t* A2; int ksplit;
};
template <class Epi>
DEV void gemm_tile(const ARows& ar, const bf16_t* __restrict__ Bt, int ldb, int K, int m0, int n0, Epi& epi) {
    const int tid = otid(), lane = tid & 63, wid = tid >> 6, wr = wid >> 1, wc = wid & 1, fr = lane & 15, fq = lane >> 4;
    const int srow = tid >> 3, sc = (tid & 7) ^ ((tid >> 4) & 7);
    const bf16_t* ap[4]; const bf16_t* bp[4];
#pragma unroll
    for (int i = 0; i < 4; ++i) {
        int r = m0 + srow + 32 * i; if (r >= ar.nvalid) r = ar.nvalid - 1;
        const size_t arow = ar.list ? (size_t)(ar.list[r] >> 1) : (size_t)(ar.rowoff + r);
        ap[i] = ar.A + arow * ar.lda + sc * 8;
        bp[i] = Bt + (size_t)(n0 + srow + 32 * i) * ldb + sc * 8;
    }
    const long a2d = ar.A2 ? (long)(ar.A2 - ar.A) - (long)ar.ksplit * 64 : 0;
    const int ks = ar.A2 ? ar.ksplit : (1 << 30);
    f32x4 acc[4][4];
#pragma unroll
    for (int mi = 0; mi < 4; ++mi)
#pragma unroll
        for (int ni = 0; ni < 4; ++ni) acc[mi][ni] = (f32x4){0.f, 0.f, 0.f, 0.f};
    const int nk = K >> 6;
    __syncthreads();
    auto stage = [&](int kt, int buf) {
        unsigned char* sa = smem + buf * 32768 + tid * 16;
#pragma unroll
        for (int i = 0; i < 4; ++i) {
            __builtin_amdgcn_global_load_lds((const unsigned*)(ap[i] + kt * 64 + (kt >= ks ? a2d : 0)), (unsigned*)(sa + i * 4096), 16, 0, 0);
            __builtin_amdgcn_global_load_lds((const unsigned*)(bp[i] + (kt >= ks ? kt - ks : kt) * 64), (unsigned*)(sa + 16384 + i * 4096), 16, 0, 0);
        }
    };
    stage(0, 0);
    const int aoff = (wr * 64 + fr) * 128, boff = 16384 + (wc * 64 + fr) * 128, sw = (fr >> 1) & 7;
    for (int kt = 0; kt < nk; ++kt) {
        asm volatile("s_waitcnt vmcnt(0)" ::: "memory");
        __syncthreads();
        if (kt + 1 < nk) stage(kt + 1, (kt + 1) & 1);
        const unsigned char* sb = smem + (kt & 1) * 32768;
#pragma unroll
        for (int kk = 0; kk < 2; ++kk) {
            const int co = ((kk * 4 + fq) ^ sw) * 16;
            bf16x8 af[4], bfr[4];
#pragma unroll
            for (int i = 0; i < 4; ++i) { af[i] = *(const bf16x8*)(sb + aoff + i * 2048 + co); bfr[i] = *(const bf16x8*)(sb + boff + i * 2048 + co); }
#pragma unroll
            for (int mi = 0; mi < 4; ++mi)
#pragma unroll
                for (int ni = 0; ni < 4; ++ni) acc[mi][ni] = __builtin_amdgcn_mfma_f32_16x16x32_bf16(bfr[ni], af[mi], acc[mi][ni], 0, 0, 0);
        }
    }
    epi(acc, m0, n0, wr, wc, fr, fq);
}

template <class F> DEV void for_tiles(int TMt, int TNt, int SM, int SN, F&& f) {
    const int G = vgrid(), vb = vbid(), nt = TMt * TNt;
    if ((G & 15) == 0 && (TMt % SM) == 0 && (TNt % SN) == 0 && SM * SN == (G >> 3)) {
        const int xcd = (vb >> 1) & 7, loc = ((vb >> 4) << 1) | (vb & 1), nsn = TNt / SN, nsup = (TMt / SM) * nsn, rounds = (nsup + 7) >> 3;
        for (int k = 0; k < rounds; ++k) { const int sup = xcd + 8 * k; if (sup >= nsup) break;
            f((sup / nsn) * SM + loc / SN, (sup % nsn) * SN + loc % SN); }
    } else {
        const int rounds = (nt + G - 1) / G;
        for (int k = 0; k < rounds; ++k) { int t = vb + k * G; if (t >= nt) t = nt - 1; f(t / TNt, t % TNt); }
    }
}

struct EpiInProj {
    const float* bias; const float* lbt; unsigned char* ws;
    static DEV void segment(int n0, int& seg, int& sb) {
        if (n0 < 1024) { seg = 0; sb = 0; } else if (n0 < 1280) { seg = 1; sb = 1024; } else if (n0 < 1536) { seg = 2; sb = 1280; }
        else if (n0 < 2560) { seg = 3; sb = 1536; } else if (n0 < 3584) { seg = 4; sb = 2560; } else if (n0 < 4608) { seg = 5; sb = 3584; }
        else if (n0 < 5632) { seg = 6; sb = 4608; } else if (n0 < 6656) { seg = 7; sb = 5632; } else { seg = 8; sb = 6656; }
    }
    DEV void operator()(f32x4 (&acc)[4][4], int m0, int n0, int wr, int wc, int fr, int fq) const {
        int seg, sb; segment(n0, seg, sb);
#pragma unroll
        for (int mi = 0; mi < 4; ++mi)
#pragma unroll
            for (int ni = 0; ni < 4; ++ni) { const int n = n0 + wc * 64 + ni * 16 + 4 * fq;
                put(seg, sb, m0 + wr * 64 + mi * 16 + fr, n, acc[mi][ni], *(const f32x4*)(bias + n), *(const f32x4*)(lbt + ((n - sb) & 1023))); }
    }
    DEV void put8(int seg, int sb, int m, int n, const f32x4& a0, const f32x4& a1, const f32x4& b0, const f32x4& b1, const f32x4& l0, const f32x4& l1) const {
        if (seg == 2 || seg == 5) { put(seg, sb, m, n, a0, b0, l0); put(seg, sb, m, n + 4, a1, b1, l1); return; }
        const int c = n - sb; const f32x4 v0 = a0 + b0, v1 = a1 + b1;
        if (seg == 0) { u32x4 o; o.x = pk2(v0[0] * 0.125f, v0[1] * 0.125f); o.y = pk2(v0[2] * 0.125f, v0[3] * 0.125f); o.z = pk2(v1[0] * 0.125f, v1[1] * 0.125f); o.w = pk2(v1[2] * 0.125f, v1[3] * 0.125f);
            *(u32x4*)((bf16_t*)(ws + OFF_QA) + (size_t)m * 1024 + c) = o; }
        else if (seg == 1) { u32x4 o; o.x = pk2(v0[0], v0[1]); o.y = pk2(v0[2], v0[3]); o.z = pk2(v1[0], v1[1]); o.w = pk2(v1[2], v1[3]); *(u32x4*)((bf16_t*)(ws + OFF_KA) + (size_t)m * 256 + c) = o; }
        else if (seg == 3) { u32x4 o; o.x = pk2(fsilu(v0[0]), fsilu(v0[1])); o.y = pk2(fsilu(v0[2]), fsilu(v0[3])); o.z = pk2(fsilu(v1[0]), fsilu(v1[1])); o.w = pk2(fsilu(v1[2]), fsilu(v1[3]));
            *(u32x4*)((bf16_t*)(ws + OFF_QH) + (size_t)m * 1024 + c) = o; }
        else if (seg == 4) {
            typedef _Float16 h16x8 __attribute__((ext_vector_type(8))); h16x8 lf;
#pragma unroll
            for (int j = 0; j < 4; ++j) {
                { const float e = fexp(-v0[j]), sg = frcp(1.0f + e), f = l0[j] + (1.0f - l0[j]) * sg; lf[j] = (_Float16)flog(fmaxf(f, 1e-30f)); }
                { const float e = fexp(-v1[j]), sg = frcp(1.0f + e), f = l1[j] + (1.0f - l1[j]) * sg; lf[4 + j] = (_Float16)flog(fmaxf(f, 1e-30f)); }
            }
            *(h16x8*)((_Float16*)(ws + OFF_LOGF) + (size_t)m * 1024 + c) = lf;
        }
        else { u32x4 o; o.x = pk2(fsigmoid(v0[0]), fsigmoid(v0[1])); o.y = pk2(fsigmoid(v0[2]), fsigmoid(v0[3])); o.z = pk2(fsigmoid(v1[0]), fsigmoid(v1[1])); o.w = pk2(fsigmoid(v1[2]), fsigmoid(v1[3]));
            *(u32x4*)((bf16_t*)(ws + OFF_GA) + (size_t)m * 1024 + c) = o; }
    }
    DEV void put(int seg, int sb, int m, int n, const f32x4& a, const f32x4& bv, const f32x4& lb) const {
            {
                const int c = n - sb;
                const f32x4 v = a + bv;
                const int b = m >> 11, s = m & 2047;
                if (seg == 0) { u32x2 o; o.x = pk2(v[0] * 0.125f, v[1] * 0.125f); o.y = pk2(v[2] * 0.125f, v[3] * 0.125f); *(u32x2*)((bf16_t*)(ws + OFF_QA) + (size_t)m * 1024 + c) = o; }
                else if (seg == 1) { u32x2 o; o.x = pk2(v[0], v[1]); o.y = pk2(v[2], v[3]); *(u32x2*)((bf16_t*)(ws + OFF_KA) + (size_t)m * 256 + c) = o; }
                else if (seg == 2) { bf16_t* d = (bf16_t*)(ws + OFF_VAT) + ((size_t)(b * 4 + (c >> 6)) * 64 + (c & 63)) * 2048 + ((s & ~15) | perm16(s & 15));
#pragma unroll
                    for (int j = 0; j < 4; ++j) d[(size_t)j * 2048] = f2bf(v[j]); }
                else if (seg == 3) { u32x2 o; o.x = pk2(fsilu(v[0]), fsilu(v[1])); o.y = pk2(fsilu(v[2]), fsilu(v[3])); *(u32x2*)((bf16_t*)(ws + OFF_QH) + (size_t)m * 1024 + c) = o; }
                else if (seg == 4) {
                    f32x4 lf; float kh[4];
#pragma unroll
                    for (int j = 0; j < 4; ++j) { const float e = fexp(-v[j]); const float sg = frcp(1.0f + e), sn = e * sg;
                        const float f = lb[j] + (1.0f - lb[j]) * sg; lf[j] = flog(fmaxf(f, 1e-30f)); kh[j] = (1.0f - lb[j]) * sn; }
                    typedef _Float16 h16x4 __attribute__((ext_vector_type(4)));
                    *(h16x4*)((_Float16*)(ws + OFF_LOGF) + (size_t)m * 1024 + c) = (h16x4){(_Float16)lf[0], (_Float16)lf[1], (_Float16)lf[2], (_Float16)lf[3]};
                }
                else if (seg == 5) { bf16_t* d = (bf16_t*)(ws + OFF_VHT) + ((size_t)(b * 8 + (c >> 7)) * 128 + (c & 127)) * 2048 + s;
#pragma unroll
                    for (int j = 0; j < 4; ++j) d[(size_t)j * 2048] = f2bf(v[j]); }
                else if (seg == 6) { u32x2 o; o.x = pk2(fsilu(v[0]), fsilu(v[1])); o.y = pk2(fsilu(v[2]), fsilu(v[3])); *(u32x2*)((bf16_t*)(ws + OFF_OG) + (size_t)m * 1024 + c) = o; }
                else { u32x2 o; o.x = pk2(fsigmoid(v[0]), fsigmoid(v[1])); o.y = pk2(fsigmoid(v[2]), fsigmoid(v[3]));
                    *(u32x2*)((bf16_t*)(ws + (seg == 7 ? OFF_GA : OFF_GH)) + (size_t)m * 1024 + c) = o; }
            }
    }
};
struct EpiMemKV {
    bf16_t* kc; bf16_t* vct;
    DEV void operator()(f32x4 (&acc)[4][4], int m0, int n0, int wr, int wc, int fr, int fq) const {
#pragma unroll
        for (int mi = 0; mi < 4; ++mi)
#pragma unroll
            for (int ni = 0; ni < 4; ++ni) {
                const int m = m0 + wr * 64 + mi * 16 + fr, n = n0 + wc * 64 + ni * 16 + 4 * fq;
                const int b = m >> 8, mm = m & 255; const f32x4 v = acc[mi][ni];
                if (n < 1024) { const int hx = n >> 8, d = n & 255; u32x2 o; o.x = pk2(v[0], v[1]); o.y = pk2(v[2], v[3]);
                    *(u32x2*)(kc + ((size_t)(b * 4 + hx) * 256 + mm) * 256 + d) = o; }
                else { const int nn = n - 1024, hx = nn >> 8, d = nn & 255; bf16_t* dp = vct + ((size_t)(b * 4 + hx) * 256 + d) * 256 + ((mm & ~31) | (8 * ((mm & 15) >> 2) + 4 * ((mm >> 4) & 1) + (mm & 3)));
#pragma unroll
                    for (int j = 0; j < 4; ++j) dp[j * 256] = f2bf(v[j]); }
            }
    }
};
struct EpiResid {
    const float* base; float* out; bf16_t* xb; float* rsq;
    DEV void operator()(f32x4 (&acc)[4][4], int m0, int n0, int wr, int wc, int fr, int fq) const {
#pragma unroll
        for (int mi = 0; mi < 4; ++mi) {
            float ss = 0.f; const int m = m0 + wr * 64 + mi * 16 + fr;
#pragma unroll
            for (int ni = 0; ni < 4; ++ni) {
                const size_t o = (size_t)m * D + n0 + wc * 64 + ni * 16 + 4 * fq;
                const f32x4 v = *(const f32x4*)(base + o) + acc[mi][ni];
                *(f32x4*)(out + o) = v;
                if (xb) { u32x2 w; w.x = pk2(v[0], v[1]); w.y = pk2(v[2], v[3]); *(u32x2*)(xb + o) = w; ss += v[0] * v[0] + v[1] * v[1] + v[2] * v[2] + v[3] * v[3]; }
            }
            if (xb) { ss += __shfl_xor(ss, 16); ss += __shfl_xor(ss, 32); if (fq == 0) rsq[(size_t)m * 16 + (n0 >> 6) + wc] = ss; }
        }
    }
};
struct EpiScaleBf16 {
    bf16_t* out; float s; const float* rsq;
    DEV void operator()(f32x4 (&acc)[4][4], int m0, int n0, int wr, int wc, int fr, int fq) const {
#pragma unroll
        for (int mi = 0; mi < 4; ++mi) {
            const int m = m0 + wr * 64 + mi * 16 + fr; const float sr = s * rsqrtf(ld_rsq(rsq + (size_t)m * 16) * (1.0f / D) + EPS);
#pragma unroll
            for (int ni = 0; ni < 4; ++ni) {
                const size_t o = (size_t)m * D + n0 + wc * 64 + ni * 16 + 4 * fq;
                const f32x4 v = acc[mi][ni] * sr; u32x2 w; w.x = pk2(v[0], v[1]); w.y = pk2(v[2], v[3]); *(u32x2*)(out + o) = w;
            }
        }
    }
};
struct EpiRouter {
    const float* brt; unsigned* cnt; int* list; float* ew; const float* rsq; float* srl; float* ewl;
    DEV void operator()(f32x4 (&acc)[4][4], int m0, int n0, int wr, int wc, int fr, int fq) const {
        float* LG = (float*)smem;
        __syncthreads();
        if (wc == 0) {
#pragma unroll
            for (int mi = 0; mi < 4; ++mi) {
                const float sr = rsqrtf(ld_rsq(rsq + (size_t)(m0 + wr * 64 + mi * 16 + fr) * 16) * (1.0f / D) + EPS);
#pragma unroll
                for (int ni = 0; ni < 3; ++ni)
#pragma unroll
                    for (int j = 0; j < 4; ++j) { const int n = ni * 16 + 4 * fq + j; if (n < NRL) LG[(wr * 64 + mi * 16 + fr) * 40 + n] = acc[mi][ni][j] * sr + brt[n]; }
                if (fq == 0) LG[(wr * 64 + mi * 16 + fr) * 40 + NRL] = sr;
            }
        }
        __syncthreads();
        const int tid = threadIdx.x & 255;
        if (tid < 128) {
            const float* lg = LG + tid * 40; const int tok = m0 + tid;
            int gi = 0; float gm = lg[0];
#pragma unroll
            for (int i = 1; i < 4; ++i) if (lg[i] > gm) { gm = lg[i]; gi = i; }
            float gs = 0.f;
#pragma unroll
            for (int i = 0; i < 4; ++i) gs += fexp(lg[i] - gm);
            const float gtop = 1.0f / gs;
            const float* el = lg + 4 + 8 * gi;
            int i1 = 0; float v1 = el[0];
#pragma unroll
            for (int i = 1; i < 8; ++i) if (el[i] > v1) { v1 = el[i]; i1 = i; }
            int i2 = -1; float v2 = -3.0e38f;
#pragma unroll
            for (int i = 0; i < 8; ++i) if (i != i1 && el[i] > v2) { v2 = el[i]; i2 = i; }
            const float e2 = fexp(v2 - v1), inv = 1.0f / (1.0f + e2);
            const float w1 = inv * gtop, w2 = e2 * inv * gtop;
            const int ea = gi * 8 + i1, eb = gi * 8 + i2;
            const float srt = lg[NRL];
            const unsigned pa = atomicAdd(cnt + ea, 1u); list[(size_t)ea * T + pa] = tok * 2; ew[tok * 2] = w1; srl[(size_t)ea * T + pa] = srt; ewl[(size_t)ea * T + pa] = w1;
            const unsigned pb = atomicAdd(cnt + eb, 1u); list[(size_t)eb * T + pb] = tok * 2 + 1; ew[tok * 2 + 1] = w2; srl[(size_t)eb * T + pb] = srt; ewl[(size_t)eb * T + pb] = w2;
        }
    }
};
struct EpiGateUp {
    bf16_t* act; int rowbase; int nvalid; const int* list; const float* rsq;
    DEV void operator()(f32x4 (&acc)[4][4], int m0, int n0, int wr, int wc, int fr, int fq) const {
        int ent[4]; float srv[4];
#pragma unroll
        for (int mi = 0; mi < 4; ++mi) { const int r = m0 + wr * 64 + mi * 16 + fr; ent[mi] = list[r < nvalid ? r : nvalid - 1]; }
#pragma unroll
        for (int mi = 0; mi < 4; ++mi) srv[mi] = rsqrtf(ld_rsq(rsq + (size_t)(ent[mi] >> 1) * 16) * (1.0f / D) + EPS);
#pragma unroll
        for (int mi = 0; mi < 4; ++mi) {
            const int r = m0 + wr * 64 + mi * 16 + fr;
            if (r < nvalid) {
                const float sr = srv[mi];
#pragma unroll
                for (int u = 0; u < 2; ++u) {
                    const f32x4 g = acc[mi][2 * u] * sr, up = acc[mi][2 * u + 1] * sr;
                    const int col = ((n0 + wc * 64) >> 1) + 16 * u + 4 * fq;
                    u32x2 w; w.x = pk2(fsilu(g[0]) * up[0], fsilu(g[1]) * up[1]); w.y = pk2(fsilu(g[2]) * up[2], fsilu(g[3]) * up[3]);
                    *(u32x2*)(act + (size_t)(rowbase + r) * EFF + col) = w;
                }
            }
        }
    }
};
struct EpiDown {
    bf16_t* yb; const int* list; const float* ew; int nvalid;
    DEV void operator()(f32x4 (&acc)[4][4], int m0, int n0, int wr, int wc, int fr, int fq) const {
        int entv[4]; float wv[4];
#pragma unroll
        for (int mi = 0; mi < 4; ++mi) { const int r = m0 + wr * 64 + mi * 16 + fr; entv[mi] = list[r < nvalid ? r : nvalid - 1]; }
#pragma unroll
        for (int mi = 0; mi < 4; ++mi) wv[mi] = ew[entv[mi]];
#pragma unroll
        for (int mi = 0; mi < 4; ++mi) {
            const int r = m0 + wr * 64 + mi * 16 + fr;
            if (r < nvalid) {
                const int ent = entv[mi]; const float w = wv[mi];
#pragma unroll
                for (int ni = 0; ni < 4; ++ni) {
                    const f32x4 v = acc[mi][ni] * w; u32x2 o; o.x = pk2(v[0], v[1]); o.y = pk2(v[2], v[3]);
                    *(u32x2*)(yb + (size_t)ent * D + n0 + wc * 64 + ni * 16 + 4 * fq) = o;
                }
            }
        }
    }
};


namespace pg8 {
#define PG8_LAS __attribute__((address_space(3)))
typedef unsigned short bf16_t;
typedef short bf16x8 __attribute__((ext_vector_type(8)));
typedef float f32x4 __attribute__((ext_vector_type(4)));
typedef unsigned u32x4 __attribute__((ext_vector_type(4)));
constexpr int BM = 256, BK = 64, HALF = 128, HTB = HALF * BK * 2  , STAGE_BYTES = 8 * HTB, NXCD = 8, WGM = 8;

__host__ __device__ __forceinline__ int lds_byte(int r, int c) { const int st = (r >> 4) * 2 + (c >> 5), rr = r & 15, cc = c & 31, ob = rr * 64 + cc * 2; return st * 1024 + (ob ^ (((ob >> 9) & 1) << 5)); }
__host__ __device__ __forceinline__ void stage_rc(int b, int& R, int& C) { const int st = b / 1024, sb = b % 1024, swz = sb ^ (((sb >> 9) & 1) << 5); R = (st >> 1) * 16 + swz / 64; C = (st & 1) * 32 + (swz % 64) / 2; }
__host__ __device__ __forceinline__ int perm32(int rho) { const int n = rho >> 4, i = rho & 15; return 8 * (i >> 2) + 4 * n + (i & 3); }

struct Unit { int pm, pn, e, c, ro, m0; };
struct Gemm { const bf16_t* A; const bf16_t* Bt; int M, N, K; };

struct StaticOrder {
    int nM, nN, nwg, G, c;
    __host__ __device__ void init(int M, int N, int G_, int c_) { nM = M / BM; nN = N / BM; nwg = nM * nN; G = G_; c = c_; }
    static constexpr bool GATHER = false;
    __device__ __forceinline__ const char* a_base(const Gemm& g, const Unit& u, size_t tstep) const { return (const char*)g.A + (size_t)u.pm * tstep; }
    __device__ __forceinline__ const char* b_base(const Gemm& g, const Unit& u, size_t tstep) const { return (const char*)g.Bt + (size_t)u.pn * tstep; }
    __device__ __forceinline__ unsigned gather(const Unit&, int) const { return 0u; }
    static constexpr bool SLABS = false;
    __device__ __forceinline__ int slabs(const Unit&) const { return 4; }
    __host__ __device__ bool next(int i, Unit& u) const {
        u.e = 0; u.c = 0; u.ro = 0; u.m0 = 0;
        const long L = (long)i * G + c; if (L >= nwg) return false;
        int wgid = (int)L; { const int q = nwg / NXCD, r = nwg % NXCD, xcd = wgid % NXCD, off = wgid / NXCD; wgid = (xcd < r ? xcd * (q + 1) : r * (q + 1) + (xcd - r) * q) + off; }
        const int nig = WGM * nN, gid = wgid / nig, fm = gid * WGM, gsz = (nM - fm) < WGM ? (nM - fm) : WGM;
        u.pm = fm + ((wgid % nig) % gsz); u.pn = (wgid % nig) / gsz; return true;
    }
    __device__ __forceinline__ void a_ready(const Unit&) const {}
    __device__ __forceinline__ void done(const Unit&) const {}
};
template <class Epi, class Sched, bool ALIGN_EPI = false, bool SP2 = false>
__device__ __forceinline__ void gemm_phase(PG8_LAS unsigned char* lds, const Gemm g, const Sched& S, const Epi& E) {
    int tid_o = threadIdx.x; asm volatile("" : "+v"(tid_o));
    const int tid = tid_o, wid = __builtin_amdgcn_readfirstlane(tid >> 6), lane = tid & 63, wr = wid >> 2, wc = wid & 3, fr = lane & 15, fq = lane >> 4;
    const int K = g.K, nt = K / BK;
    unsigned voffA[2], voffB[2];
#pragma unroll
    for (int i = 0; i < 2; ++i) { int R, C; stage_rc(tid * 16 + i * 8192, R, C); const int Rb = Epi::PERM ? ((R & ~31) + perm32(R & 31)) : R;
        voffA[i] = (unsigned)(R * K + C) * 2u; voffB[i] = (unsigned)(Rb * K + C) * 2u; }
    const size_t kstep = (size_t)(BK * 2);
    const size_t hstep = (size_t)HALF * K * 2;
    const size_t tstep = 2 * hstep;
    const unsigned ldsw = (unsigned)wid * 1024u;
    const int aoff = lds_byte(wr * 64 + fr, fq * 8), boff = lds_byte(wc * 32 + fr, fq * 8);
#define PG8_SA(b, h) (((b) * 2 + (h)) * HTB)
#define PG8_SB(b, h) ((4 + (b) * 2 + (h)) * HTB)
#define PG8_STAGE(bufoff, gbase, voff) do { _Pragma("unroll") for (int _i = 0; _i < 2; ++_i) \
        __builtin_amdgcn_global_load_lds((const unsigned*)((const char*)(gbase) + (voff)[_i]), (PG8_LAS unsigned*)(lds + (bufoff) + ldsw + _i * 8192), 16, 0, 0); } while (0)
#define PG8_LDA(dst, b, h) do { _Pragma("unroll") for (int m = 0; m < 4; ++m) _Pragma("unroll") for (int k = 0; k < 2; ++k) dst[m][k] = *(const PG8_LAS bf16x8*)(lds + PG8_SA(b, h) + aoff + m * 2048 + k * 1024); } while (0)
#define PG8_LDB(dst, b, h) do { _Pragma("unroll") for (int n = 0; n < 2; ++n) _Pragma("unroll") for (int k = 0; k < 2; ++k) dst[n][k] = *(const PG8_LAS bf16x8*)(lds + PG8_SB(b, h) + boff + n * 2048 + k * 1024); } while (0)
#define PG8_MMA(ai, bj, At, Bt) do { __builtin_amdgcn_s_setprio(1); _Pragma("unroll") for (int m = 0; m < 4; ++m) _Pragma("unroll") for (int n = 0; n < 2; ++n) _Pragma("unroll") for (int k = 0; k < 2; ++k) \
        acc[ai][bj][m][n] = __builtin_amdgcn_mfma_f32_16x16x32_bf16(Bt[n][k], At[m][k], acc[ai][bj][m][n], 0, 0, 0); __builtin_amdgcn_s_setprio(0); } while (0)
#define PG8_WAIT_V(n) asm volatile("s_waitcnt vmcnt(" #n ")" ::: "memory")
#define PG8_WAIT_L(n) asm volatile("s_waitcnt lgkmcnt(" #n ")" ::: "memory")
#define PG8_BAR __builtin_amdgcn_s_barrier()
#define PG8_SCHED __builtin_amdgcn_sched_barrier(0)
    constexpr bool GATHER = Sched::GATHER;
    static_assert(!GATHER || SP2, "gathered A rows: SP2 path only");
    unsigned goffC[2][2] = {{0u, 0u}, {0u, 0u}}, goffN[2][2] = {{0u, 0u}, {0u, 0u}};
    auto goff_ent = [&](const Unit& u, unsigned (&ent)[2][2]) {
#pragma unroll
        for (int h = 0; h < 2; ++h)
#pragma unroll
            for (int i = 0; i < 2; ++i) { int R, C; stage_rc(tid * 16 + i * 8192, R, C); ent[h][i] = S.gather(u, h * HALF + R); }
    };
    auto goff_set = [&](unsigned (&go)[2][2], const unsigned (&ent)[2][2]) {
#pragma unroll
        for (int h = 0; h < 2; ++h)
#pragma unroll
            for (int i = 0; i < 2; ++i) { int R, C; stage_rc(tid * 16 + i * 8192, R, C); go[h][i] = (ent[h][i] * (unsigned)K + (unsigned)C) * 2u; }
    };
#define PG8_STAGE_A(bufoff, base, h, nx) do { if constexpr (GATHER) { _Pragma("unroll") for (int _i = 0; _i < 2; ++_i) { const unsigned _o = (nx) ? goffN[h][_i] : goffC[h][_i]; \
        __builtin_amdgcn_global_load_lds((const unsigned*)((const char*)(base) + _o), (PG8_LAS unsigned*)(lds + (bufoff) + ldsw + _i * 8192), 16, 0, 0); } } \
    else PG8_STAGE(bufoff, (base) + (h) * hstep, voffA); } while (0)
    Unit cur, nxt; int ui = 0;
    if (!S.next(0, cur)) return;
    if constexpr (GATHER) { unsigned ent[2][2]; goff_ent(cur, ent); goff_set(goffC, ent); Unit u1; if (S.next(1, u1)) { goff_ent(u1, ent); goff_set(goffN, ent); } }
    f32x4 acc[2][2][4][2];
#pragma unroll
    for (int a = 0; a < 2; ++a)
#pragma unroll
        for (int b = 0; b < 2; ++b)
#pragma unroll
            for (int m = 0; m < 4; ++m)
#pragma unroll
                for (int n = 0; n < 2; ++n) acc[a][b][m][n] = (f32x4){0.f, 0.f, 0.f, 0.f};
    bf16x8 At[4][2], B0[2][2], B1[2][2];
    constexpr bool SLABS = Sched::SLABS;
    int nvc = S.slabs(cur); bool do0 = !SLABS || wr < nvc, do1 = !SLABS || 2 + wr < nvc;
    const char* cA = S.a_base(g, cur, tstep); const char* cB = S.b_base(g, cur, tstep);
    S.a_ready(cur);
    if constexpr (SP2) {
        PG8_STAGE(PG8_SB(0, 0), cB, voffB); PG8_STAGE(PG8_SB(0, 1), cB + hstep, voffB); PG8_STAGE_A(PG8_SA(0, 0), cA, 0, false); PG8_STAGE_A(PG8_SA(0, 1), cA, 1, false);
        if (wr == 1) PG8_BAR;
        PG8_WAIT_V(2); PG8_BAR;
        PG8_STAGE(PG8_SB(1, 0), cB + kstep, voffB); PG8_STAGE_A(PG8_SA(1, 0), cA + kstep, 0, false); PG8_STAGE(PG8_SB(1, 1), cB + hstep + kstep, voffB);
        PG8_WAIT_V(6); PG8_BAR;
    } else {
        PG8_STAGE(PG8_SB(0, 0), cB, voffB); PG8_STAGE(PG8_SA(0, 0), cA, voffA); PG8_STAGE(PG8_SB(0, 1), cB + hstep, voffB); PG8_STAGE(PG8_SA(0, 1), cA + hstep, voffA);
        if (wr == 1) PG8_BAR;
        PG8_WAIT_V(4); PG8_BAR;
        PG8_STAGE(PG8_SB(1, 0), cB + kstep, voffB); PG8_STAGE(PG8_SA(1, 0), cA + kstep, voffA); PG8_STAGE(PG8_SB(1, 1), cB + hstep + kstep, voffB);
        PG8_WAIT_V(6); PG8_BAR;
    }
    for (;;) {
        const bool has_next = S.next(ui + 1, nxt);
        const char* nA = has_next ? S.a_base(g, nxt, tstep) : cA; const char* nB = has_next ? S.b_base(g, nxt, tstep) : cB;
        for (int t = 0; t < nt; t += 2) {
            const bool last = (t == nt - 2);
            const char* a1 = cA + (size_t)(t + 1) * kstep;
            const char* a2 = last ? nA : cA + (size_t)(t + 2) * kstep; const char* b2 = last ? nB : cB + (size_t)(t + 2) * kstep;
            const char* a3 = a2 + kstep; const char* b3 = b2 + kstep;
            if (last && has_next) S.a_ready(nxt);
            const bool lastn = last && has_next;
            if constexpr (SP2) {
            if (do0) { PG8_LDB(B0, 0, 0); PG8_LDB(B1, 0, 1); } PG8_SCHED; if (do0) PG8_LDA(At, 0, 0); PG8_STAGE_A(PG8_SA(1, 1), a1, 1, false);
            PG8_WAIT_V(8); PG8_WAIT_L(0); PG8_BAR; if (do0) { PG8_MMA(0, 0, At, B0); PG8_MMA(0, 1, At, B1); } PG8_BAR; PG8_SCHED;
            if (do1) PG8_LDA(At, 0, 1); PG8_STAGE(PG8_SB(0, 0), b2, voffB); PG8_STAGE(PG8_SB(0, 1), b2 + hstep, voffB); PG8_STAGE_A(PG8_SA(0, 0), a2, 0, lastn);
            PG8_WAIT_V(8); PG8_WAIT_L(0); PG8_BAR; if (do1) { PG8_MMA(1, 0, At, B0); PG8_MMA(1, 1, At, B1); } PG8_BAR; PG8_SCHED;
            if (do0) { PG8_LDB(B0, 1, 0); PG8_LDB(B1, 1, 1); } PG8_SCHED; if (do0) PG8_LDA(At, 1, 0); PG8_STAGE_A(PG8_SA(0, 1), a2, 1, lastn);
            PG8_WAIT_V(8); PG8_WAIT_L(0); PG8_BAR; if (do0) { PG8_MMA(0, 0, At, B0); PG8_MMA(0, 1, At, B1); } PG8_BAR; PG8_SCHED;
            if (do1) PG8_LDA(At, 1, 1); PG8_STAGE(PG8_SB(1, 0), b3, voffB); PG8_STAGE(PG8_SB(1, 1), b3 + hstep, voffB); PG8_STAGE_A(PG8_SA(1, 0), a3, 0, lastn);
            PG8_WAIT_V(8); PG8_WAIT_L(0); PG8_BAR; if (do1) { PG8_MMA(1, 0, At, B0); PG8_MMA(1, 1, At, B1); } PG8_BAR; PG8_SCHED;
            } else {
            PG8_LDB(B0, 0, 0); PG8_SCHED; PG8_LDA(At, 0, 0); PG8_STAGE(PG8_SA(1, 1), a1 + hstep, voffA);
            PG8_WAIT_L(8); PG8_BAR; PG8_WAIT_L(0); PG8_MMA(0, 0, At, B0); PG8_BAR; PG8_SCHED;
            PG8_LDB(B1, 0, 1); PG8_STAGE(PG8_SB(0, 0), b2, voffB);
            PG8_BAR; PG8_WAIT_L(0); PG8_MMA(0, 1, At, B1); PG8_BAR;
            PG8_LDA(At, 0, 1); PG8_STAGE(PG8_SA(0, 0), a2, voffA);
            PG8_BAR; PG8_WAIT_L(0); PG8_MMA(1, 0, At, B0); PG8_BAR; PG8_SCHED;
            PG8_STAGE(PG8_SB(0, 1), b2 + hstep, voffB);
            PG8_WAIT_V(6); PG8_BAR; PG8_MMA(1, 1, At, B1); PG8_BAR;
            PG8_LDB(B0, 1, 0); PG8_SCHED; PG8_LDA(At, 1, 0); PG8_STAGE(PG8_SA(0, 1), a2 + hstep, voffA);
            PG8_WAIT_L(8); PG8_BAR; PG8_WAIT_L(0); PG8_MMA(0, 0, At, B0); PG8_BAR; PG8_SCHED;
            PG8_LDB(B1, 1, 1); PG8_STAGE(PG8_SB(1, 0), b3, voffB);
            PG8_BAR; PG8_WAIT_L(0); PG8_MMA(0, 1, At, B1); PG8_BAR;
            PG8_LDA(At, 1, 1); PG8_STAGE(PG8_SA(1, 0), a3, voffA);
            PG8_BAR; PG8_WAIT_L(0); PG8_MMA(1, 0, At, B0); PG8_BAR; PG8_SCHED;
            PG8_STAGE(PG8_SB(1, 1), b3 + hstep, voffB);
            PG8_WAIT_V(6); PG8_BAR; PG8_MMA(1, 1, At, B1); PG8_BAR;
            }
        }
        if constexpr (ALIGN_EPI) { if (wr == 0) PG8_BAR; }
        if constexpr (GATHER) {
            Unit u2; const bool has2 = has_next && S.next(ui + 2, u2);
            unsigned ent[2][2] = {{0u, 0u}, {0u, 0u}};
            if (has2) goff_ent(u2, ent);
            E(acc, cur, wr, wc, fr, fq);
#pragma unroll
            for (int h = 0; h < 2; ++h)
#pragma unroll
                for (int i = 0; i < 2; ++i) goffC[h][i] = goffN[h][i];
            if (has2) goff_set(goffN, ent);
        } else
        if constexpr (!Epi::AFTER_DRAIN) { E(acc, cur, wr, wc, fr, fq); S.done(cur); }
        if (!has_next) break;
#pragma unroll
        for (int a = 0; a < 2; ++a)
#pragma unroll
            for (int b = 0; b < 2; ++b)
#pragma unroll
                for (int m = 0; m < 4; ++m)
#pragma unroll
                    for (int n = 0; n < 2; ++n) acc[a][b][m][n] = (f32x4){0.f, 0.f, 0.f, 0.f};
        cur = nxt; cA = nA; cB = nB; ++ui; nvc = S.slabs(cur); do0 = !SLABS || wr < nvc; do1 = !SLABS || 2 + wr < nvc;
        if constexpr (ALIGN_EPI) { if (wr == 1) PG8_BAR; }
    }
    PG8_WAIT_V(0);
    if constexpr (!ALIGN_EPI) { if (wr == 0) PG8_BAR; }
    PG8_BAR;
    if constexpr (Epi::AFTER_DRAIN) { E.fused(acc, cur, wr, wc, fr, fq, lds, wid, lane); S.done(cur); }
#undef PG8_SA
#undef PG8_SB
#undef PG8_STAGE
#undef PG8_STAGE_A
#undef PG8_LDA
#undef PG8_LDB
#undef PG8_MMA
#undef PG8_WAIT_V
#undef PG8_WAIT_L
#undef PG8_BAR
#undef PG8_SCHED
}
}

struct Epi8InProj {
    static constexpr bool PERM = true, AFTER_DRAIN = false;
    EpiInProj e; const float* rstd;
    DEV void operator()(const f32x4 (&acc)[2][2][4][2], const pg8::Unit& u, int wr, int wc, int fr, int fq) const {
        int seg, sb; EpiInProj::segment(u.pn * 256, seg, sb);
        auto& A = const_cast<f32x4 (&)[2][2][4][2]>(acc);
        {
            float rs[2][4];
#pragma unroll
            for (int ai = 0; ai < 2; ++ai)
#pragma unroll
                for (int m = 0; m < 4; ++m) rs[ai][m] = rstd[u.pm * 256 + ai * 128 + wr * 64 + m * 16 + fr];
#pragma unroll
            for (int ai = 0; ai < 2; ++ai)
#pragma unroll
                for (int m = 0; m < 4; ++m)
#pragma unroll
                    for (int bj = 0; bj < 2; ++bj)
#pragma unroll
                        for (int n = 0; n < 2; ++n) A[ai][bj][m][n] *= rs[ai][m];
        }
        if (seg == 6 || seg == 8) {
            const int hd = (seg == 6 ? 0 : 4) + ((u.pn * 256 - sb) >> 8), cc = wc * 32 + 8 * fq;
            f32x4 bo[2], bg[2];
#pragma unroll
            for (int n = 0; n < 2; ++n) { bo[n] = *(const f32x4*)(e.bias + 4608 + hd * 128 + cc + n * 4); bg[n] = *(const f32x4*)(e.bias + 6656 + hd * 128 + cc + n * 4); }
            bf16_t* gp = (bf16_t*)(e.ws + OFF_OG) + hd * 128 + cc;
#pragma unroll
            for (int ai = 0; ai < 2; ++ai)
#pragma unroll
                for (int m = 0; m < 4; ++m) {
                    u32x4 o;
#pragma unroll
                    for (int n = 0; n < 2; ++n) {
                        const f32x4 a = acc[ai][0][m][n] + bo[n], g = acc[ai][1][m][n] + bg[n];
                        const unsigned x = pk2(fsilu(a[0]) * fsigmoid(g[0]), fsilu(a[1]) * fsigmoid(g[1])), y = pk2(fsilu(a[2]) * fsigmoid(g[2]), fsilu(a[3]) * fsigmoid(g[3]));
                        if (n == 0) { o.x = x; o.y = y; } else { o.z = x; o.w = y; }
                    }
                    *(u32x4*)(gp + (size_t)(u.pm * 256 + ai * 128 + wr * 64 + m * 16 + fr) * 1024) = o;
                }
            return;
        }
        const int n00 = u.pn * 256 + wc * 32 + 8 * fq;
        f32x4 bv[2][2], lb[2][2];
#pragma unroll
        for (int bj = 0; bj < 2; ++bj)
#pragma unroll
            for (int n = 0; n < 2; ++n) { bv[bj][n] = *(const f32x4*)(e.bias + n00 + bj * 128 + n * 4); lb[bj][n] = *(const f32x4*)(e.lbt + ((n00 + bj * 128 + n * 4 - sb) & 1023)); }
#pragma unroll
        for (int ai = 0; ai < 2; ++ai)
#pragma unroll
            for (int m = 0; m < 4; ++m)
#pragma unroll
                for (int bj = 0; bj < 2; ++bj)
                    e.put8(seg, sb, u.pm * 256 + ai * 128 + wr * 64 + m * 16 + fr, n00 + bj * 128, acc[ai][bj][m][0], acc[ai][bj][m][1], bv[bj][0], bv[bj][1], lb[bj][0], lb[bj][1]);
    }
};
struct Epi8MemKV {
    static constexpr bool PERM = false, AFTER_DRAIN = false;
    bf16_t* kc; bf16_t* vct;
    DEV void operator()(const f32x4 (&acc)[2][2][4][2], const pg8::Unit& u, int wr, int wc, int fr, int fq) const {
#pragma unroll
        for (int ai = 0; ai < 2; ++ai)
#pragma unroll
            for (int m = 0; m < 4; ++m)
#pragma unroll
                for (int bj = 0; bj < 2; ++bj)
#pragma unroll
                    for (int n = 0; n < 2; ++n) {
                        const int mrow = u.pm * 256 + ai * 128 + wr * 64 + m * 16 + fr, ncol = u.pn * 256 + bj * 128 + wc * 32 + n * 16 + 4 * fq;
                        const int b = mrow >> 8, mm = mrow & 255; const f32x4 v = acc[ai][bj][m][n];
                        if (ncol < 1024) { const int hx = ncol >> 8, d = ncol & 255; u32x2 o; o.x = pk2(v[0], v[1]); o.y = pk2(v[2], v[3]);
                            *(u32x2*)(kc + ((size_t)(b * 4 + hx) * 256 + mm) * 256 + d) = o; }
                        else { const int nn = ncol - 1024, hx = nn >> 8, d = nn & 255; bf16_t* dp = vct + ((size_t)(b * 4 + hx) * 256 + d) * 256 + ((mm & ~31) | (8 * ((mm & 15) >> 2) + 4 * ((mm >> 4) & 1) + (mm & 3)));
#pragma unroll
                            for (int j = 0; j < 4; ++j) dp[j * 256] = f2bf(v[j]); }
                    }
    }
};
struct Epi8Resid {
    static constexpr bool PERM = false, AFTER_DRAIN = false;
    const bf16_t* base; bf16_t* xb; float* rsq;
    DEV void operator()(const f32x4 (&acc)[2][2][4][2], const pg8::Unit& u, int wr, int wc, int fr, int fq) const {
        const size_t o00 = (size_t)(u.pm * 256 + wr * 64 + fr) * D + u.pn * 256 + wc * 32 + 4 * fq;
        u32x2 bv[2][4][2][2];
#pragma unroll
        for (int ai = 0; ai < 2; ++ai)
#pragma unroll
            for (int m = 0; m < 4; ++m)
#pragma unroll
                for (int bj = 0; bj < 2; ++bj)
#pragma unroll
                    for (int n = 0; n < 2; ++n) bv[ai][m][bj][n] = *(const u32x2*)(base + o00 + (size_t)(ai * 128 + m * 16) * D + bj * 128 + n * 16);
#pragma unroll
        for (int ai = 0; ai < 2; ++ai)
#pragma unroll
            for (int m = 0; m < 4; ++m) {
                float ss = 0.f;
#pragma unroll
                for (int bj = 0; bj < 2; ++bj)
#pragma unroll
                    for (int n = 0; n < 2; ++n) {
                        const size_t o = o00 + (size_t)(ai * 128 + m * 16) * D + bj * 128 + n * 16; const u32x2 bb = bv[ai][m][bj][n]; const f32x4 a = acc[ai][bj][m][n];
                        const float x0 = bflo(bb.x) + a[0], x1 = bfhi(bb.x) + a[1], x2 = bflo(bb.y) + a[2], x3 = bfhi(bb.y) + a[3];
                        u32x2 w; w.x = pk2(x0, x1); w.y = pk2(x2, x3); *(u32x2*)(xb + o) = w;
                        ss += x0 * x0 + x1 * x1 + x2 * x2 + x3 * x3;
                    }
                ss += __shfl_xor(ss, 16); ss += __shfl_xor(ss, 32);
                if (fq == 0) rsq[(size_t)(u.pm * 256 + ai * 128 + wr * 64 + m * 16 + fr) * 16 + 4 * u.pn + wc] = ss;
            }
    }
};
struct Epi8ScaleBf16 {
    static constexpr bool PERM = false, AFTER_DRAIN = false;
    bf16_t* out; float s; const float* rsq;
    DEV void operator()(const f32x4 (&acc)[2][2][4][2], const pg8::Unit& u, int wr, int wc, int fr, int fq) const {
        float srv[2][4];
#pragma unroll
        for (int ai = 0; ai < 2; ++ai)
#pragma unroll
            for (int m = 0; m < 4; ++m) srv[ai][m] = s * rsqrtf(ld_rsq(rsq + (size_t)(u.pm * 256 + ai * 128 + wr * 64 + m * 16 + fr) * 16) * (1.0f / D) + EPS);
#pragma unroll
        for (int ai = 0; ai < 2; ++ai)
#pragma unroll
            for (int m = 0; m < 4; ++m) {
                const int mrow = u.pm * 256 + ai * 128 + wr * 64 + m * 16 + fr; const float sr = srv[ai][m];
#pragma unroll
                for (int bj = 0; bj < 2; ++bj)
#pragma unroll
                    for (int n = 0; n < 2; ++n) {
                        const size_t o = (size_t)mrow * D + u.pn * 256 + bj * 128 + wc * 32 + n * 16 + 4 * fq;
                        const f32x4 v = acc[ai][bj][m][n] * sr; u32x2 w; w.x = pk2(v[0], v[1]); w.y = pk2(v[2], v[3]); *(u32x2*)(out + o) = w;
                    }
            }
    }
};
template <class Epi> DEV void dense_gemm(const bf16_t* A, const bf16_t* Bt, int M, int N, int K, const Epi& E, int c0 = 0, int gsub = 0) {
    pg8::Gemm g{A, Bt, M, N, K};
    if (gsub > 0 && ((int)blockIdx.x < c0 || (int)blockIdx.x >= c0 + gsub)) return;
    pg8::StaticOrder S; S.init(M, N, gsub > 0 ? gsub : (int)gridDim.x, (int)blockIdx.x - c0);
    pg8::gemm_phase<Epi, pg8::StaticOrder, true, true>((PG8_LAS unsigned char*)smem_all, g, S, E);
}

DEV void swa_naive_unit(const Params& p, int l, int unit) {
    unsigned char* ws = p.ws;
    const int tid = otid(), h = unit & 15, nb = (unit >> 4) & 15, b = unit >> 8, kvh = h >> 2;
    bf16_t* Ks = (bf16_t*)smem;
    bf16_t* Vt = (bf16_t*)(smem + 32768);
    const bf16_t* KA = (const bf16_t*)(ws + OFF_KA); const bf16_t* VAT = (const bf16_t*)(ws + OFF_VAT);
    __syncthreads();
    for (int i = tid; i < 2048; i += 256) {
        { const int kj = i >> 3, ch = i & 7, s = 128 * (nb - 1) + kj; u32x4 v = (u32x4){0u, 0u, 0u, 0u};
          if (s >= 0) v = *(const u32x4*)(KA + (size_t)(b * SEQ + s) * 256 + kvh * 64 + ch * 8);
          *(u32x4*)(Ks + kj * 64 + ch * 8) = v; }
        { const int d = i >> 5, ch = i & 31, s0 = 128 * (nb - 1) + ch * 8; u32x4 v = (u32x4){0u, 0u, 0u, 0u};
          if (s0 >= 0) v = *(const u32x4*)(VAT + ((size_t)(b * 4 + kvh) * 64 + d) * SEQ + s0);
          const unsigned vw[4] = {v.x, v.y, v.z, v.w};
#pragma unroll
          for (int e = 0; e < 8; ++e) { const int pos = ch * 8 + e, key = (pos & ~15) | perm16(pos & 15); Vt[d * 256 + key] = (bf16_t)((e & 1) ? (vw[e >> 1] >> 16) : (vw[e >> 1] & 0xffffu)); } }
    }
    __syncthreads();
    const int q = tid & 127, dh = tid >> 7, tok = b * SEQ + nb * 128 + q;
    float qv[64];
    { const bf16_t* qp = (const bf16_t*)(ws + OFF_QA) + (size_t)tok * 1024 + h * 64;
#pragma unroll
      for (int c = 0; c < 8; ++c) { const u32x4 w = *(const u32x4*)(qp + c * 8);
          qv[c * 8 + 0] = bflo(w.x); qv[c * 8 + 1] = bfhi(w.x); qv[c * 8 + 2] = bflo(w.y); qv[c * 8 + 3] = bfhi(w.y);
          qv[c * 8 + 4] = bflo(w.z); qv[c * 8 + 5] = bfhi(w.z); qv[c * 8 + 6] = bflo(w.w); qv[c * 8 + 7] = bfhi(w.w); } }
    float mrun = p.attn_sinks[l * 16 + h], lrun = 1.0f, o[32];
#pragma unroll
    for (int d = 0; d < 32; ++d) o[d] = 0.f;
    int k_lo = q + 1; if (nb == 0 && k_lo < 128) k_lo = 128;
    for (int kj = k_lo; kj <= q + 128; ++kj) {
        float s = 0.f;
#pragma unroll
        for (int c = 0; c < 8; ++c) { const u32x4 w = *(const u32x4*)(Ks + kj * 64 + c * 8);
            s += qv[c * 8 + 0] * bflo(w.x) + qv[c * 8 + 1] * bfhi(w.x) + qv[c * 8 + 2] * bflo(w.y) + qv[c * 8 + 3] * bfhi(w.y)
               + qv[c * 8 + 4] * bflo(w.z) + qv[c * 8 + 5] * bfhi(w.z) + qv[c * 8 + 6] * bflo(w.w) + qv[c * 8 + 7] * bfhi(w.w); }
        const float mn = fmaxf(mrun, s), a = fexp(mrun - mn), pe = fexp(s - mn);
        lrun = lrun * a + pe; mrun = mn;
#pragma unroll
        for (int d = 0; d < 32; ++d) o[d] = o[d] * a + pe * bf2f(Vt[(dh * 32 + d) * 256 + kj]);
    }
    const float inv = 1.0f / lrun;
    const bf16_t* ga = (const bf16_t*)(ws + OFF_GA) + (size_t)tok * 1024 + h * 64 + dh * 32;
    bf16_t* mo = (bf16_t*)(ws + OFF_MIXA) + (size_t)tok * 1024 + h * 64 + dh * 32;
#pragma unroll
    for (int d = 0; d < 32; ++d) mo[d] = f2bf(o[d] * inv * bf2f(ga[d]));
}

DEV void hgrn_naive_unit(const Params& p, int l, int unit) {
    unsigned char* ws = p.ws;
    const int tid = otid(), lane = tid & 63, wid = tid >> 6, h = unit & 7, b = unit >> 3;
    const int dv = tid & 127, kh2 = tid >> 7;
    float* Lq = (float*)smem;
    float* Lk = Lq + 2048; float* Lf = Lk + 2048;
    float* Lo = Lf + 2048;
    const bf16_t* QH = (const bf16_t*)(ws + OFF_QH); const bf16_t* KH = (const bf16_t*)(ws + OFF_KH); const float* LOGF = (const float*)(ws + OFF_LOGF);
    const bf16_t* vrow = (const bf16_t*)(ws + OFF_VHT) + ((size_t)(b * 8 + h) * 128 + dv) * SEQ;
    float st[64];
#pragma unroll
    for (int k = 0; k < 64; ++k) st[k] = 0.f;
    for (int t0 = 0; t0 < SEQ; t0 += 16) {
        __syncthreads();
        for (int i = tid; i < 2048; i += 256) { const int tt = i >> 7, k = i & 127; const size_t g = (size_t)(b * SEQ + t0 + tt) * 1024 + h * 128 + k;
            Lq[i] = bf2f(QH[g]); Lk[i] = bf2f(KH[g]); Lf[i] = fexp(LOGF[g]); }
        const u32x4 va = *(const u32x4*)(vrow + t0), vb = *(const u32x4*)(vrow + t0 + 8);
        float vv[16] = {bflo(va.x), bfhi(va.x), bflo(va.y), bfhi(va.y), bflo(va.z), bfhi(va.z), bflo(va.w), bfhi(va.w),
                        bflo(vb.x), bfhi(vb.x), bflo(vb.y), bfhi(vb.y), bflo(vb.z), bfhi(vb.z), bflo(vb.w), bfhi(vb.w)};
        __syncthreads();
#pragma unroll
        for (int tt = 0; tt < 16; ++tt) {
            const float v = vv[tt]; float o = 0.f;
            const float* fq_ = Lq + tt * 128 + kh2 * 64; const float* fk_ = Lk + tt * 128 + kh2 * 64; const float* ff_ = Lf + tt * 128 + kh2 * 64;
#pragma unroll
            for (int k = 0; k < 64; ++k) { st[k] = ff_[k] * st[k] + fk_[k] * v; o += fq_[k] * st[k]; }
            Lo[(kh2 * 16 + tt) * 128 + dv] = o;
        }
        __syncthreads();
#pragma unroll
        for (int i = 0; i < 4; ++i) {
            const int tt = wid * 4 + i; const size_t g = (size_t)(b * SEQ + t0 + tt) * 1024 + h * 128;
            const float o0 = Lo[tt * 128 + lane] + Lo[(16 + tt) * 128 + lane], o1 = Lo[tt * 128 + 64 + lane] + Lo[(16 + tt) * 128 + 64 + lane];
            const float ss = wave_sum(o0 * o0 + o1 * o1), rstd = rsqrtf(ss * (1.0f / 128.0f) + EPS);
            const float w0 = p.hg_out_norm[l * 128 + lane], w1 = p.hg_out_norm[l * 128 + 64 + lane];
            const bf16_t* og = (const bf16_t*)(ws + OFF_OG) + g; const bf16_t* gh = (const bf16_t*)(ws + OFF_GH) + g; bf16_t* mh = (bf16_t*)(ws + OFF_MIXH) + g;
            mh[lane] = f2bf(o0 * rstd * w0 * bf2f(og[lane]) * bf2f(gh[lane]));
            mh[64 + lane] = f2bf(o1 * rstd * w1 * bf2f(og[64 + lane]) * bf2f(gh[64 + lane]));
        }
    }
}

DEV void xattn_naive_unit(const Params& p, int l, int unit) {
    unsigned char* ws = p.ws;
    const int tid = otid(), lane = tid & 63, wid = tid >> 6, tt0 = (unit & 63) * 32, hx = (unit >> 6) & 3, b = unit >> 8;
    float* Qs = (float*)smem;
    float* Ss = Qs + 8192;
    const bf16_t* QC = (const bf16_t*)(ws + OFF_QC);
    const bf16_t* kc = (const bf16_t*)(ws + OFF_KC) + (size_t)l * TMEM * D + (size_t)(b * 4 + hx) * 65536;
    const bf16_t* vct = (const bf16_t*)(ws + OFF_VCT) + (size_t)l * TMEM * D + (size_t)(b * 4 + hx) * 65536;
    __syncthreads();
    for (int i = tid; i < 8192; i += 256) { const int tk = i >> 8, d = i & 255; Qs[i] = bf2f(QC[(size_t)(b * SEQ + tt0 + tk) * 1024 + hx * 256 + d]); }
    __syncthreads();
    float acc[32];
#pragma unroll
    for (int i = 0; i < 32; ++i) acc[i] = 0.f;
    for (int dc = 0; dc < 32; ++dc) {
        const u32x4 w = *(const u32x4*)(kc + (size_t)tid * 256 + dc * 8);
        const float kv[8] = {bflo(w.x), bfhi(w.x), bflo(w.y), bfhi(w.y), bflo(w.z), bfhi(w.z), bflo(w.w), bfhi(w.w)};
#pragma unroll
        for (int tk = 0; tk < 32; ++tk) { const float* qp = Qs + tk * 256 + dc * 8;
#pragma unroll
            for (int j = 0; j < 8; ++j) acc[tk] += qp[j] * kv[j]; }
    }
#pragma unroll
    for (int tk = 0; tk < 32; ++tk) Ss[tk * 256 + tid] = acc[tk];
    __syncthreads();
#pragma unroll 1
    for (int i = 0; i < 8; ++i) {
        float* sp = Ss + (wid * 8 + i) * 256;
        const float s0 = sp[lane], s1 = sp[lane + 64], s2 = sp[lane + 128], s3 = sp[lane + 192];
        const float m = wave_max(fmaxf(fmaxf(s0, s1), fmaxf(s2, s3)));
        const float e0 = fexp(s0 - m), e1 = fexp(s1 - m), e2 = fexp(s2 - m), e3 = fexp(s3 - m);
        const float inv = 1.0f / wave_sum(e0 + e1 + e2 + e3);
        sp[lane] = e0 * inv; sp[lane + 64] = e1 * inv; sp[lane + 128] = e2 * inv; sp[lane + 192] = e3 * inv;
    }
    __syncthreads();
#pragma unroll
    for (int i = 0; i < 32; ++i) acc[i] = 0.f;
    for (int jc = 0; jc < 32; ++jc) {
        const u32x4 w = *(const u32x4*)(vct + (size_t)tid * 256 + jc * 8);
        const float vv[8] = {bflo(w.x), bfhi(w.x), bflo(w.y), bfhi(w.y), bflo(w.z), bfhi(w.z), bflo(w.w), bfhi(w.w)};
#pragma unroll
        for (int tk = 0; tk < 32; ++tk) { const float* pp = Ss + tk * 256 + (jc >> 2) * 32;
#pragma unroll
            for (int j = 0; j < 8; ++j) { const int pos = (jc & 3) * 8 + j; acc[tk] += pp[16 * ((pos >> 2) & 1) + 4 * (pos >> 3) + (pos & 3)] * vv[j]; } }
    }
    bf16_t* oc = (bf16_t*)(ws + OFF_OC);
#pragma unroll
    for (int tk = 0; tk < 32; ++tk) oc[(size_t)(b * SEQ + tt0 + tk) * 1024 + hx * 256 + tid] = f2bf(acc[tk]);
}


#define MFMA32(a, b, c) __builtin_amdgcn_mfma_f32_32x32x16_bf16((a), (b), (c), 0, 0, 0)
#define MFMA16(a, b, c) __builtin_amdgcn_mfma_f32_16x16x32_bf16((a), (b), (c), 0, 0, 0)
DEV f32x16 zero16() { f32x16 z; for (int i = 0; i < 16; ++i) z[i] = 0.f; return z; }

constexpr int HF_BUF = 19456;
constexpr int HF_TOT = 2 * HF_BUF, HF_Q3 = HF_TOT + 2048, HF_K3D = HF_Q3 + 8192, HF_K3O = HF_K3D + 8192, HF_RS = HF_K3O + 4096, HF_HW = HF_RS + 1024, HF_OUT = HF_HW + 512, HF_GP = HF_OUT + 16384;
DEV void hf_bar() { asm volatile("s_waitcnt lgkmcnt(0)" ::: "memory"); __builtin_amdgcn_s_barrier(); asm volatile("" ::: "memory"); }
DEV void hgrn_fused_block(const Params& p, int l, int unit) {
    unsigned char* ws = p.ws;
    unsigned char* L = smem_all;
    const int tid = otid(), lane = tid & 63, w = __builtin_amdgcn_readfirstlane(tid >> 6);
    const int h = unit & 7, b = unit >> 3;
    __syncthreads();
    if (vhalf() != 0) {
        const int k0 = 2 * lane, tq = w, sub = tq >> 1, qh = tq & 1;
        const size_t gb = (size_t)(b * SEQ + 8 * tq) * 1024 + h * 128 + k0;
        const _Float16* LOGF = (const _Float16*)(ws + OFF_LOGF) + gb; const bf16_t* QH = (const bf16_t*)(ws + OFF_QH) + gb;
        const int kq = (k0 & ~15) | perm16(k0 & 15);
        const int c1 = kq >> 3, o1 = (kq & 7) * 2;
        const int c3 = k0 >> 3, o3 = (k0 & 7) * 2;
        const int k2o = 8192 + k0 * 64 + ((tq ^ ((k0 >> 2) & 3)) << 4);
        const bf16_t* GPp = (const bf16_t*)(ws + OFF_OG) + gb;
        const int gpo = ((lane >> 2) << 4) + (lane & 3) * 4;
        typedef _Float16 h16x2 __attribute__((ext_vector_type(2)));
        h16x2 LF0[8], LF1[8]; float2 bl[8]; unsigned Qa[8], Qb[8], Ga[8], Gb[8];
        auto ld_lf = [&](int n, h16x2 (&lf)[8]) {
            const _Float16* s = LOGF + (size_t)(n < 63 ? n : 63) * 32768;
#pragma unroll
            for (int j = 0; j < 8; ++j) lf[j] = *(const h16x2*)(s + j * 1024);
        };
        auto ld_qk = [&](int n, unsigned (&q)[8], unsigned (&gp)[8]) {
            const size_t o = (size_t)(n < 63 ? n : 63) * 32768;
#pragma unroll
            for (int j = 0; j < 8; ++j) { q[j] = *(const unsigned*)(QH + o + j * 1024); gp[j] = *(const unsigned*)(GPp + o + j * 1024); }
        };
        auto gates = [&](int n, const unsigned (&gp)[8]) {
            unsigned char* GPt = L + HF_GP + (n & 1) * 8192;
#pragma unroll
            for (int j = 0; j < 8; ++j) { const int t = 8 * tq + j, tx = 8 * qh + j; *(unsigned*)(GPt + t * 256 + (gpo ^ (tx << 4))) = gp[j]; }
        };
        auto expo = [&](int n, const unsigned (&q)[8]) {
            const float* TOT = (const float*)(L + HF_TOT) + k0;
            const float2 t0 = *(const float2*)(TOT), t1 = *(const float2*)(TOT + 128), t2 = *(const float2*)(TOT + 256), t3 = *(const float2*)(TOT + 384);
            const float s0x = t0.x + t1.x, s0y = t0.y + t1.y, s1x = t2.x + t3.x, s1y = t2.y + t3.y, blx = s0x + s1x, bly = s0y + s1y;
            const float qox = qh ? (sub ? t2.x : t0.x) : 0.f, qoy = qh ? (sub ? t2.y : t0.y) : 0.f;
            unsigned char* B = L + (n & 1) * HF_BUF;
            unsigned k2a[4], k2b[4]; float px = 0.f, py = 0.f;
            const float ecx = fexp(sub ? s0x : s1x), ecy = fexp(sub ? s0y : s1y);
            const float m1x = sub ? ecx : 1.f, m1y = sub ? ecy : 1.f, m2x = sub ? 1.f : ecx, m2y = sub ? 1.f : ecy;
            const float c3x_ = sub ? s1x : s0x, c3y_ = sub ? s1y : s0y;
#pragma unroll
            for (int j = 0; j < 8; ++j) {
                const int t = 8 * tq + j, tx = 8 * qh + j;
                const float bx = bl[j].x + qox, by = bl[j].y + qoy;
                const float lfx = j ? bl[j].x - bl[j - 1].x : bl[0].x, lfy = j ? bl[j].y - bl[j - 1].y : bl[0].y;
                const float qx = bflo(q[j]), qy = bfhi(q[j]), kx = 1.0f - fexp(lfx), ky = 1.0f - fexp(lfy);
                const float q3x = qx * fexp(bx), q3y = qy * fexp(by);
                const float kox = kx * fexp(c3x_ - bx), koy = ky * fexp(c3y_ - by);
                const float kdx = kx * fexp(fminf(-bx, 80.f)), kdy = ky * fexp(fminf(-by, 80.f));
                const float k2x = kox * m2x, k2y = koy * m2y;
                const int ro1 = t * 256 + ((c1 ^ tx) << 4) + o1, ro3 = t * 256 + ((c3 ^ tx) << 4) + o3;
                *(unsigned*)(B + ro1) = pk2(q3x * m1x, q3y * m1y);
                *(unsigned*)(L + HF_Q3 + ro3) = pk2(q3x, q3y);
                *(unsigned*)(L + HF_K3D + ro3) = pk2(kdx, kdy);
                if (!sub) *(unsigned*)(L + HF_K3O + ro3) = pk2(kox, koy);
                if (j & 1) { k2a[j >> 1] = pk2(px, k2x); k2b[j >> 1] = pk2(py, k2y); } else { px = k2x; py = k2y; }
            }
            *(u32x4*)(B + k2o) = (u32x4){k2a[0], k2a[1], k2a[2], k2a[3]};
            *(u32x4*)(B + k2o + 64) = (u32x4){k2b[0], k2b[1], k2b[2], k2b[3]};
            if (tq == 3) *(float2*)(B + 18432 + k0 * 4) = make_float2(fexp(blx), fexp(bly));
        };
        auto amat = [&](int n) {
            unsigned char* AMl = L + (n & 1) * HF_BUF + 16384;
            const int fr = lane & 15, fq = lane >> 4;
            if (tq == 3) { *(u32x2*)(AMl + fr * 64 + (((2 + (fq >> 1)) ^ ((fr >> 2) & 3)) << 4) + 8 * (fq & 1)) = (u32x2){0u, 0u}; }
            else {
                const int ta = tq == 0 ? 0 : 16, sa = tq == 1 ? 16 : 0;
                const unsigned char* Bs = L + (tq == 2 ? HF_K3O : HF_K3D);
                f32x4 acc = (f32x4){0.f, 0.f, 0.f, 0.f};
#pragma unroll
                for (int k4 = 0; k4 < 4; ++k4) {
                    const bf16x8 qf = *(const bf16x8*)(L + HF_Q3 + (ta + fr) * 256 + (((k4 * 4 + fq) ^ fr) << 4));
                    const bf16x8 kf = *(const bf16x8*)(Bs + (sa + fr) * 256 + (((k4 * 4 + fq) ^ fr) << 4));
                    acc = MFMA16(kf, qf, acc);
                }
                if (tq != 2) {
#pragma unroll
                    for (int j = 0; j < 4; ++j) if (4 * fq + j > fr) acc[j] = 0.f;
                }
                u32x2 o; o.x = pk2(acc[0], acc[1]); o.y = pk2(acc[2], acc[3]);
                const int t = ta + fr;
                *(u32x2*)(AMl + t * 64 + ((((sa >> 3) + (fq >> 1)) ^ ((t >> 2) & 3)) << 4) + 8 * (fq & 1)) = o;
            }
        };
        auto csum = [&](const h16x2 (&lf)[8]) {
            float rx = 0.f, ry = 0.f;
#pragma unroll
            for (int j = 0; j < 8; ++j) { rx += (float)lf[j][0]; ry += (float)lf[j][1]; bl[j] = make_float2(rx, ry); }
            *(float2*)(L + HF_TOT + tq * 512 + k0 * 4) = make_float2(rx, ry);
        };
        auto pstep = [&](int c, unsigned (&q)[8], unsigned (&gp)[8], h16x2 (&lf)[8]) {
            if (c + 1 >= 0 && c + 1 < 64) { expo(c + 1, q); gates(c + 1, gp); }
            ld_qk(c + 3, q, gp);
            hf_bar();
            if (c + 1 >= 0 && c + 1 < 64) amat(c + 1);
            csum(lf); ld_lf(c + 4, lf);
            hf_bar();
        };
        ld_lf(0, LF0); ld_lf(1, LF1); ld_qk(0, Qa, Ga);
#pragma unroll 1
        for (int c = -2; c < 64; c += 2) { pstep(c, Qb, Gb, LF0); pstep(c + 1, Qa, Ga, LF1); }
    } else {
        const int l31 = lane & 31, hh = lane >> 5;
        const bf16_t* vrow = (const bf16_t*)(ws + OFF_VHT) + ((size_t)unit * 128 + 32 * w + l31) * SEQ + 8 * hh;
        const size_t tok0 = (size_t)(b * SEQ + l31) * 1024 + h * 128 + 32 * w + 4 * hh;
        const int q1f = l31 * 256, q1x = l31 & 15;
        const int k2f = 8192 + l31 * 64, k2x = (l31 >> 2) & 3;
        const int amf = 16384 + l31 * 64;
        const int ddf = 18432 + 16 * hh;
        float* HW = (float*)(L + HF_HW);
        float* RS = (float*)(L + HF_RS);
        const float* hwp = HW + 32 * w + 4 * hh;
        if (tid < 128) HW[tid] = p.hg_out_norm[l * 128 + tid];
        f32x16 S[4], oT = zero16();
#pragma unroll
        for (int i = 0; i < 4; ++i) S[i] = zero16();
        bf16x8 V0[2], V1[2];
        auto ld_v = [&](int n, bf16x8 (&v)[2]) { const int cn = n < 63 ? n : 63; v[0] = *(const bf16x8*)(vrow + cn * 32); v[1] = *(const bf16x8*)(vrow + cn * 32 + 16); };
        auto consA = [&](int c, const bf16x8 (&vf)[2]) {
            const unsigned char* B = L + (c & 1) * HF_BUF;
            bf16x8 qfr[8], afr[2];
#pragma unroll
            for (int i = 0; i < 8; ++i) qfr[i] = *(const bf16x8*)(B + q1f + (((2 * i + hh) ^ q1x) << 4));
#pragma unroll
            for (int s2 = 0; s2 < 2; ++s2) afr[s2] = *(const bf16x8*)(B + amf + (((2 * s2 + hh) ^ k2x) << 4));
            __builtin_amdgcn_sched_barrier(0);
            oT = zero16();
#pragma unroll
            for (int i = 0; i < 8; ++i) oT = MFMA32(pack8(S[i >> 1], i & 1), qfr[i], oT);
#pragma unroll
            for (int s2 = 0; s2 < 2; ++s2) oT = MFMA32(vf[s2], afr[s2], oT);
#pragma unroll
            for (int kb = 0; kb < 4; ++kb) {
                f32x4 dd[4]; bf16x8 kfr[2];
#pragma unroll
                for (int g = 0; g < 4; ++g) dd[g] = *(const f32x4*)(B + ddf + kb * 128 + g * 32);
                kfr[0] = *(const bf16x8*)(B + k2f + kb * 2048 + (((0 + hh) ^ k2x) << 4)); kfr[1] = *(const bf16x8*)(B + k2f + kb * 2048 + (((2 + hh) ^ k2x) << 4));
#pragma unroll
                for (int g = 0; g < 4; ++g) { S[kb][4 * g + 0] *= dd[g][0]; S[kb][4 * g + 1] *= dd[g][1]; S[kb][4 * g + 2] *= dd[g][2]; S[kb][4 * g + 3] *= dd[g][3]; }
                S[kb] = MFMA32(kfr[0], vf[0], S[kb]); S[kb] = MFMA32(kfr[1], vf[1], S[kb]);
            }
            float ss = 0.f;
#pragma unroll
            for (int i = 0; i < 16; ++i) ss += oT[i] * oT[i];
            ss += __shfl_xor(ss, 32);
            if (hh == 0) RS[(c & 1) * 128 + w * 32 + l31] = ss;
        };
        auto consB = [&](int c) {
            const float tot = RS[(c & 1) * 128 + l31] + RS[(c & 1) * 128 + 32 + l31] + RS[(c & 1) * 128 + 64 + l31] + RS[(c & 1) * 128 + 96 + l31];
            const float rstd = rsqrtf(tot * (1.0f / 128.0f) + EPS);
            unsigned char* O = L + HF_OUT + (c & 1) * 8192 + l31 * 256 + 8 * hh;
            const unsigned char* GPt = L + HF_GP + (c & 1) * 8192 + l31 * 256 + 8 * hh;
#pragma unroll
            for (int g = 0; g < 4; ++g) {
                const f32x4 hw = *(const f32x4*)(hwp + 8 * g);
                const u32x2 gp = *(const u32x2*)(GPt + (((4 * w + g) ^ (l31 & 15)) << 4));
                const float v0 = oT[4 * g + 0] * rstd * hw[0] * bflo(gp.x), v1 = oT[4 * g + 1] * rstd * hw[1] * bfhi(gp.x);
                const float v2 = oT[4 * g + 2] * rstd * hw[2] * bflo(gp.y), v3 = oT[4 * g + 3] * rstd * hw[3] * bfhi(gp.y);
                u32x2 o; o.x = pk2(v0, v1); o.y = pk2(v2, v3); *(u32x2*)(O + (((4 * w + g) ^ (l31 & 15)) << 4)) = o;
            }
        };
        auto out_store = [&](int c) {
            const unsigned char* O = L + HF_OUT + (c & 1) * 8192;
            bf16_t* mrow = (bf16_t*)(ws + OFF_MIXA) + (size_t)(b * SEQ + (c < 0 ? 0 : c) * 32) * 2048 + 1024 + h * 128;
#pragma unroll
            for (int i = 0; i < 2; ++i) {
                const int idx = tid + 256 * i, t = idx >> 4, j = idx & 15;
                const u32x4 v = *(const u32x4*)(O + t * 256 + ((j ^ (t & 15)) << 4));
                *(u32x4*)(mrow + (size_t)t * 2048 + j * 8) = v;
            }
        };
        auto cstep = [&](int c, bf16x8 (&vf)[2]) {
            consA(c, vf); ld_v(c + 2, vf); out_store(c - 1);
            hf_bar();
            consB(c);
            hf_bar();
        };
        ld_v(0, V0); ld_v(1, V1);
        hf_bar(); hf_bar(); hf_bar(); hf_bar();
#pragma unroll 1
        for (int c = 0; c < 64; c += 2) { cstep(c, V0); cstep(c + 1, V1); }
        out_store(63);
    }
}

DEV void swa_fast_unit(const Params& p, int l, int unit) {
    unsigned char* ws = p.ws;
    const int tid = otid(), lane = tid & 63, w = tid >> 6, l31 = lane & 31, hh = lane >> 5;
    const int wu = __builtin_amdgcn_readfirstlane(w);
    const int h = unit & 15, nb = (unit >> 4) & 15, b = unit >> 8, kvh = h >> 2;
    const size_t tok = (size_t)b * SEQ + nb * 128 + 32 * w + l31;
    const bf16_t* qp = (const bf16_t*)(ws + OFF_QA) + tok * 1024 + h * 64 + 8 * hh;
    bf16x8 qf[4];
#pragma unroll
    for (int s2 = 0; s2 < 4; ++s2) qf[s2] = *(const bf16x8*)(qp + 16 * s2);
    const int s0 = 128 * (nb - 1);
    {
        const bf16_t* KA = (const bf16_t*)(ws + OFF_KA) + (size_t)b * SEQ * 256 + kvh * 64;
        const bf16_t* VT = (const bf16_t*)(ws + OFF_VAT) + (size_t)(b * 4 + kvh) * 64 * SEQ;
        __syncthreads();
#pragma unroll
        for (int j = 0; j < 8; ++j) {
            const int pc = wu * 8 + j;
            { const int row = pc * 8 + (lane >> 3), pos = lane & 7, sc = pos ^ ((row >> 1) & 7); int s = s0 + row; if (s < 0) s += 128;
              __builtin_amdgcn_global_load_lds((const unsigned*)(KA + (size_t)s * 256 + sc * 8), (unsigned*)(smem + pc * 1024 + lane * 16), 16, 0, 0); }
            { const int row = pc * 2 + (lane >> 5), pos = lane & 31, sc = pos ^ (row & 15); int s = s0 + sc * 8; if (s < 0) s += 128;
              __builtin_amdgcn_global_load_lds((const unsigned*)(VT + (size_t)row * SEQ + s), (unsigned*)(smem + 32768 + pc * 1024 + lane * 16), 16, 0, 0); }
        }
        asm volatile("s_waitcnt vmcnt(0)" ::: "memory");
        __syncthreads();
    }
    const int ks0 = s0 + 32 * w;
    f32x16 sc[5];
#pragma unroll
    for (int i = 0; i < 5; ++i) {
        sc[i] = zero16();
        const int row = 32 * (w + i) + l31; const unsigned char* kb = smem + row * 128; const int kx = (row >> 1) & 7;
#pragma unroll
        for (int s2 = 0; s2 < 4; ++s2) { const bf16x8 kf = *(const bf16x8*)(kb + (((2 * s2 + hh) ^ kx) << 4)); sc[i] = MFMA32(kf, qf[s2], sc[i]); }
    }
    const float sink = p.attn_sinks[l * 16 + h];
    float m = sink;
#pragma unroll
    for (int i = 0; i < 5; ++i) {
        const bool bv = (ks0 + 32 * i) >= 0;
#pragma unroll
        for (int r = 0; r < 16; ++r) {
            const int kr = (r & 3) + 8 * (r >> 2) + 4 * hh;
            const bool ok = bv && (i == 0 ? kr > l31 : (i == 4 ? kr <= l31 : true));
            sc[i][r] = ok ? sc[i][r] : -1.0e30f;
            m = fmaxf(m, sc[i][r]);
        }
    }
    m = fmaxf(m, __shfl_xor(m, 32));
    float lsum = 0.f;
#pragma unroll
    for (int i = 0; i < 5; ++i)
#pragma unroll
        for (int r = 0; r < 16; ++r) { const float e = sc[i][r] > -1.0e29f ? fexp(sc[i][r] - m) : 0.f; sc[i][r] = e; lsum += e; }
    lsum += __shfl_xor(lsum, 32);
    const float inv = 1.0f / (lsum + fexp(sink - m));
    f32x16 o0 = zero16(), o1 = zero16();
    {
        const unsigned char* v0b = smem + 32768 + l31 * 512; const unsigned char* v1b = v0b + 32 * 512; const int vx = l31 & 15;
#pragma unroll
        for (int i = 0; i < 5; ++i)
#pragma unroll
            for (int s2 = 0; s2 < 2; ++s2) {
                const int c = 4 * (w + i) + 2 * s2 + hh;
                const bf16x8 pb = pack8(sc[i], s2);
                const bf16x8 va = *(const bf16x8*)(v0b + ((c ^ vx) << 4)), vb = *(const bf16x8*)(v1b + ((c ^ vx) << 4));
                o0 = MFMA32(va, pb, o0); o1 = MFMA32(vb, pb, o1);
            }
    }
    const bf16_t* ga = (const bf16_t*)(ws + OFF_GA) + tok * 1024 + h * 64 + 4 * hh;
    bf16_t* mo = (bf16_t*)(ws + OFF_MIXA) + tok * 2048 + h * 64 + 4 * hh;
#pragma unroll
    for (int g = 0; g < 4; ++g) {
        const u32x2 ga0 = *(const u32x2*)(ga + 8 * g), ga1 = *(const u32x2*)(ga + 32 + 8 * g);
        u32x2 a, c2;
        a.x = pk2(o0[4 * g + 0] * inv * bflo(ga0.x), o0[4 * g + 1] * inv * bfhi(ga0.x)); a.y = pk2(o0[4 * g + 2] * inv * bflo(ga0.y), o0[4 * g + 3] * inv * bfhi(ga0.y));
        c2.x = pk2(o1[4 * g + 0] * inv * bflo(ga1.x), o1[4 * g + 1] * inv * bfhi(ga1.x)); c2.y = pk2(o1[4 * g + 2] * inv * bflo(ga1.y), o1[4 * g + 3] * inv * bfhi(ga1.y));
        *(u32x2*)(mo + 8 * g) = a; *(u32x2*)(mo + 32 + 8 * g) = c2;
    }
}

DEV void xa_stage(const bf16_t* __restrict__ src, int slot, int tid) {
#pragma unroll
    for (int i = 0; i < 4; ++i) {
        const int q = i * 256 + tid, r = q >> 5, pp = q & 31;
        __builtin_amdgcn_global_load_lds((const unsigned*)(src + r * 256 + ((pp ^ (r & 15)) << 3)), (unsigned*)(smem + slot * 16384 + q * 16), 16, 0, 0);
    }
}
DEV int perm32(int kk) { return 8 * ((kk & 15) >> 2) + 4 * (kk >> 4) + (kk & 3); }
DEV int iperm32(int pos) { return 16 * ((pos >> 2) & 1) + 4 * (pos >> 3) + (pos & 3); }
DEV void xattn_fast_unit(const Params& p, int l, int unit) {
    unsigned char* ws = p.ws;
    const int tid = otid(), lane = tid & 63, w = tid >> 6, fr = lane & 15, fq = lane >> 4;
    const int qt = unit & 31, hx = (unit >> 5) & 3, b = unit >> 7;
    const size_t tok = (size_t)b * SEQ + qt * 64 + 16 * w + fr;
    const bf16_t* kc = (const bf16_t*)(ws + OFF_KC) + (size_t)l * TMEM * D + (size_t)(b * 4 + hx) * 65536;
    const bf16_t* vct = (const bf16_t*)(ws + OFF_VCT) + (size_t)l * TMEM * D + (size_t)(b * 4 + hx) * 65536;
    const bf16_t* qp = (const bf16_t*)(ws + OFF_QC) + tok * 1024 + hx * 256 + 8 * fq;
    bf16x8 qf[8];
#pragma unroll
    for (int s2 = 0; s2 < 8; ++s2) qf[s2] = *(const bf16x8*)(qp + 32 * s2);
    const int fo = fr * 512;
    __syncthreads();
    xa_stage(kc, 0, tid);
    f32x4 sc[16];
#pragma unroll
    for (int i = 0; i < 8; ++i) {
        asm volatile("s_waitcnt vmcnt(0)" ::: "memory");
        __syncthreads();
        if (i + 1 < 8) xa_stage(kc + (size_t)(i + 1) * 8192, (i + 1) & 1, tid); else xa_stage(vct, 0, tid);
        const unsigned char* B = smem + (i & 1) * 16384 + fo;
        sc[2 * i] = (f32x4){0.f, 0.f, 0.f, 0.f}; sc[2 * i + 1] = (f32x4){0.f, 0.f, 0.f, 0.f};
#pragma unroll
        for (int s2 = 0; s2 < 8; ++s2) {
            const bf16x8 k0 = *(const bf16x8*)(B + (((4 * s2 + fq) ^ fr) << 4)), k1 = *(const bf16x8*)(B + 8192 + (((4 * s2 + fq) ^ fr) << 4));
            sc[2 * i] = MFMA16(k0, qf[s2], sc[2 * i]); sc[2 * i + 1] = MFMA16(k1, qf[s2], sc[2 * i + 1]);
        }
        __builtin_amdgcn_sched_barrier(0);
    }
    float m = sc[0][0];
#pragma unroll
    for (int i = 0; i < 16; ++i)
#pragma unroll
        for (int j = 0; j < 4; ++j) m = fmaxf(m, sc[i][j]);
    m = fmaxf(m, __shfl_xor(m, 16)); m = fmaxf(m, __shfl_xor(m, 32));
    float ls = 0.f;
#pragma unroll
    for (int i = 0; i < 16; ++i)
#pragma unroll
        for (int j = 0; j < 4; ++j) { const float e = fexp(sc[i][j] - m); sc[i][j] = e; ls += e; }
    ls += __shfl_xor(ls, 16); ls += __shfl_xor(ls, 32);
    const float inv = 1.0f / ls;
    bf16x8 pbf[8];
#pragma unroll
    for (int u = 0; u < 8; ++u) {
        u32x4 wv; wv.x = pk2(sc[2 * u][0] * inv, sc[2 * u][1] * inv); wv.y = pk2(sc[2 * u][2] * inv, sc[2 * u][3] * inv);
        wv.z = pk2(sc[2 * u + 1][0] * inv, sc[2 * u + 1][1] * inv); wv.w = pk2(sc[2 * u + 1][2] * inv, sc[2 * u + 1][3] * inv);
        pbf[u] = __builtin_bit_cast(bf16x8, wv);
    }
    bf16_t* oc = (bf16_t*)(ws + OFF_OC) + tok * 1024 + hx * 256 + 4 * fq;
#pragma unroll 1
    for (int db = 0; db < 8; ++db) {
        asm volatile("s_waitcnt vmcnt(0)" ::: "memory");
        __syncthreads();
        if (db + 1 < 8) xa_stage(vct + (size_t)(db + 1) * 8192, (db + 1) & 1, tid);
        const unsigned char* B = smem + (db & 1) * 16384 + fo;
        f32x4 oa = (f32x4){0.f, 0.f, 0.f, 0.f}, ob = (f32x4){0.f, 0.f, 0.f, 0.f};
#pragma unroll
        for (int u = 0; u < 8; ++u) {
            const bf16x8 va = *(const bf16x8*)(B + (((4 * u + fq) ^ fr) << 4)), vb = *(const bf16x8*)(B + 8192 + (((4 * u + fq) ^ fr) << 4));
            oa = MFMA16(va, pbf[u], oa); ob = MFMA16(vb, pbf[u], ob);
        }
        u32x2 o0, o1; o0.x = pk2(oa[0], oa[1]); o0.y = pk2(oa[2], oa[3]); o1.x = pk2(ob[0], ob[1]); o1.y = pk2(ob[2], ob[3]);
        *(u32x2*)(oc + db * 32) = o0; *(u32x2*)(oc + db * 32 + 16) = o1;
    }
}

DEV void router_phase(const Params& p, int l, unsigned* cnt, int* list, float* ew) {
    unsigned char* ws = p.ws;
    const int tid = otid512(), lane = tid & 63, w = tid >> 6, fr = lane & 15, fq = lane >> 4;
    const bf16_t* WR = (const bf16_t*)(ws + OFF_W + (size_t)l * W_LAYER + W_R);
    const float* brt = p.b_router + l * NRL;
    const float* rsq = (const float*)(ws + OFF_RSQ) + (size_t)(2 * l + 1) * T * 16;
    float* srl = (float*)(ws + OFF_SRL); float* ewl = (float*)(ws + OFF_EWL);
    __syncthreads();
#pragma unroll
    for (int i = 0; i < 12; ++i) { const int q = tid + 512 * i, n = q >> 7, c = q & 127; *(u32x4*)(smem_all + n * 2048 + ((c ^ (n & 15)) << 4)) = *(const u32x4*)(WR + (size_t)n * 1024 + c * 8); }
    __syncthreads();
    float* LG = (float*)(smem_all + 98304 + w * 2560);
    unsigned* lcnt = (unsigned*)(smem_all + 98304 + 8 * 2560);
    const int G8 = (int)gridDim.x * 8, npass = (T / 16 + G8 - 1) / G8;
    for (int ps = 0; ps < npass; ++ps) {
        const int g = ps * G8 + (int)gridDim.x * w + (int)blockIdx.x;
        const bool act = g < T / 16;
        if (tid < 32) lcnt[tid] = 0u;
        __syncthreads();
        int ea = 0, eb = 0; unsigned pa = 0u, pb = 0u; float w1 = 0.f, w2 = 0.f, srt = 0.f;
        if (act) {
            const int tok = g * 16 + fr;
            const bf16_t* xr = (const bf16_t*)(ws + OFF_HB) + (size_t)tok * 1024 + 8 * fq;
            const float sr = rsqrtf(ld_rsq(rsq + (size_t)tok * 16) * (1.0f / D) + EPS);
            f32x4 acc[3];
#pragma unroll
            for (int nt = 0; nt < 3; ++nt) acc[nt] = (f32x4){0.f, 0.f, 0.f, 0.f};
#pragma unroll
            for (int kb = 0; kb < 4; ++kb) {
                bf16x8 xf[8];
#pragma unroll
                for (int i = 0; i < 8; ++i) xf[i] = *(const bf16x8*)(xr + (kb * 8 + i) * 32);
#pragma unroll
                for (int i = 0; i < 8; ++i) {
                    const int c = (kb * 8 + i) * 4 + fq;
#pragma unroll
                    for (int nt = 0; nt < 3; ++nt) {
                        const bf16x8 wf = *(const bf16x8*)(smem_all + (16 * nt + fr) * 2048 + ((c ^ fr) << 4));
                        acc[nt] = MFMA16(wf, xf[i], acc[nt]);
                    }
                }
            }
#pragma unroll
            for (int nt = 0; nt < 3; ++nt)
#pragma unroll
                for (int j = 0; j < 4; ++j) { const int n = nt * 16 + 4 * fq + j; if (n < NRL) LG[fr * 40 + n] = acc[nt][j] * sr + brt[n]; }
            if (fq == 0) LG[fr * 40 + NRL] = sr;
            asm volatile("s_waitcnt lgkmcnt(0)" ::: "memory");
            if (lane < 16) {
                const float* lg = LG + lane * 40;
                int gi = 0; float gm = lg[0];
#pragma unroll
                for (int i = 1; i < 4; ++i) if (lg[i] > gm) { gm = lg[i]; gi = i; }
                float gs = 0.f;
#pragma unroll
                for (int i = 0; i < 4; ++i) gs += fexp(lg[i] - gm);
                const float gtop = 1.0f / gs;
                const float* el = lg + 4 + 8 * gi;
                int i1 = 0; float v1 = el[0];
#pragma unroll
                for (int i = 1; i < 8; ++i) if (el[i] > v1) { v1 = el[i]; i1 = i; }
                int i2 = -1; float v2 = -3.0e38f;
#pragma unroll
                for (int i = 0; i < 8; ++i) if (i != i1 && el[i] > v2) { v2 = el[i]; i2 = i; }
                const float e2 = fexp(v2 - v1), inv = 1.0f / (1.0f + e2);
                w1 = inv * gtop; w2 = e2 * inv * gtop;
                ea = gi * 8 + i1; eb = gi * 8 + i2; srt = lg[NRL];
                pa = atomicAdd(lcnt + ea, 1u); pb = atomicAdd(lcnt + eb, 1u);
            }
        }
        __syncthreads();
        if (tid < 32) { const unsigned n = lcnt[tid]; if (n) lcnt[tid] = atomicAdd(cnt + tid * 32, n); }
        __syncthreads();
        if (act && lane < 16) {
            const int tk = g * 16 + lane;
            const size_t qa = (size_t)ea * T + lcnt[ea] + pa, qb = (size_t)eb * T + lcnt[eb] + pb;
            list[qa] = tk * 2; ew[tk * 2] = w1; srl[qa] = srt; ewl[qa] = w1;
            list[qb] = tk * 2 + 1; ew[tk * 2 + 1] = w2; srl[qb] = srt; ewl[qb] = w2;
        }
        __syncthreads();
    }
}

constexpr int NPL = 13, NPH = 1 + 2 * NPL;
enum { PL_INPROJ = 0, PL_MIX, PL_SUM, PL_OUTPROJ, PL_NORM2, PL_CQ, PL_XATTN, PL_CO, PL_NORM3, PL_ROUTER, PL_GATEUP, PL_DOWN, PL_COMBINE };

struct MoeTab { int c, ts, ro, total; };
template <int SH> DEV MoeTab moe_tables(const unsigned* cnt) {
    int lane = threadIdx.x & 63; asm volatile("" : "+v"(lane));
    MoeTab t; t.c = lane < NEXP ? (int)cnt[lane * 32] : 0;
    const int nt = (t.c + (1 << SH) - 1) >> SH;
    int it = nt, ir = t.c;
#pragma unroll
    for (int d = 1; d < 32; d <<= 1) { const int a = __shfl_up(it, d), b = __shfl_up(ir, d); if (lane >= d) { it += a; ir += b; } }
    t.ts = it - nt; t.ro = ir - t.c; t.total = __shfl(it, 31);
    return t;
}
template <int SH> DEV void moe_item(const MoeTab& t, int mt, int& e, int& c, int& ro, int& m0) {
    const int lane = threadIdx.x & 63;
    const unsigned long long bal = __ballot(lane < NEXP && t.ts <= mt && mt < t.ts + ((t.c + (1 << SH) - 1) >> SH));
    e = __ffsll((long long)bal) - 1;
    c = __shfl(t.c, e); ro = __shfl(t.ro, e); m0 = (mt - __shfl(t.ts, e)) << SH;
}
DEV void moe_unit_table(const unsigned* cnt) {
    __syncthreads();
    if (threadIdx.x < 64) {
        int lane = threadIdx.x; asm volatile("" : "+v"(lane));
        const int c = lane < NEXP ? (int)cnt[lane * 32] : 0;
        const int nt = (c + 255) >> 8, rem = c - ((nt - 1) << 8), sm = (nt > 0 && rem <= 128) ? 1 : 0, nb = nt - sm;
        int pb = nb, ps = sm, pr = c;
#pragma unroll
        for (int d = 1; d < 32; d <<= 1) { const int x = __shfl_up(pb, d), y = __shfl_up(ps, d), z = __shfl_up(pr, d); if (lane >= d) { pb += x; ps += y; pr += z; } }
        const int tb = __shfl(pb, 31), ts = __shfl(ps, 31), ro = pr - c;
        int4* tab = (int4*)(smem_all + LDS_MOE);
        for (int k = 0; k < nb; ++k) tab[pb - nb + k] = make_int4(lane, c, ro, k << 8);
        if (sm) tab[tb + ps - 1] = make_int4(lane, c, ro, (nt - 1) << 8);
        if (lane == 0) *(int*)(smem_all + LDS_MOE + 160 * 16) = tb + ts;
    }
    __syncthreads();
}
template <bool GATHER_> struct MoeOrder {
    static constexpr bool GATHER = GATHER_;
    int total, G, c; const int* list;
    DEV bool next(int i, pg8::Unit& u) const {
        const int L = i * G + c; u.pm = 0; u.pn = L & 3; u.e = 0; u.c = 1; u.ro = 0; u.m0 = 0;
        if (L >= 4 * total) return false;
        const int4 q = ((const int4*)(smem_all + LDS_MOE))[L >> 2];
        u.e = __builtin_amdgcn_readfirstlane(q.x); u.c = __builtin_amdgcn_readfirstlane(q.y); u.ro = __builtin_amdgcn_readfirstlane(q.z); u.m0 = __builtin_amdgcn_readfirstlane(q.w);
        return true;
    }
    DEV const char* a_base(const pg8::Gemm& g, const pg8::Unit& u, size_t) const { return GATHER ? (const char*)g.A : (const char*)g.A + (size_t)(u.ro + u.m0) * g.K * 2; }
    DEV const char* b_base(const pg8::Gemm& g, const pg8::Unit& u, size_t tstep) const { return (const char*)g.Bt + (size_t)u.e * g.N * g.K * 2 + (size_t)u.pn * tstep; }
    static constexpr bool SLABS = true;
    DEV int slabs(const pg8::Unit& u) const { const int v = (u.c - u.m0 + 63) >> 6; return v < 4 ? v : 4; }
    DEV unsigned gather(const pg8::Unit& u, int row) const { int r = u.m0 + row; r = r < u.c ? r : u.c - 1; return (unsigned)(list[(size_t)u.e * T + r] >> 1); }
    DEV void a_ready(const pg8::Unit&) const {}
    DEV void done(const pg8::Unit&) const {}
};
struct Epi8GateUp {
    static constexpr bool PERM = false, AFTER_DRAIN = false;
    bf16_t* act; const float* srl;
    DEV void operator()(const f32x4 (&acc)[2][2][4][2], const pg8::Unit& u, int wr, int wc, int fr, int fq) const {
        float srv[2][4];
#pragma unroll
        for (int ai = 0; ai < 2; ++ai)
#pragma unroll
            for (int m = 0; m < 4; ++m) { const int r = u.m0 + ai * 128 + wr * 64 + m * 16 + fr; srv[ai][m] = srl[(size_t)u.e * T + (r < u.c ? r : u.c - 1)]; }
#pragma unroll
        for (int ai = 0; ai < 2; ++ai)
#pragma unroll
            for (int m = 0; m < 4; ++m) {
                const int r = u.m0 + ai * 128 + wr * 64 + m * 16 + fr;
                if (r < u.c) {
                    const float sr = srv[ai][m];
#pragma unroll
                    for (int bj = 0; bj < 2; ++bj) {
                        const f32x4 g = acc[ai][bj][m][0] * sr, up = acc[ai][bj][m][1] * sr;
                        u32x2 w; w.x = pk2(fsilu(g[0]) * up[0], fsilu(g[1]) * up[1]); w.y = pk2(fsilu(g[2]) * up[2], fsilu(g[3]) * up[3]);
                        *(u32x2*)(act + (size_t)(u.ro + r) * EFF + ((u.pn * 256 + bj * 128 + wc * 32) >> 1) + 4 * fq) = w;
                    }
                }
            }
    }
};
struct Epi8Down {
    static constexpr bool PERM = false, AFTER_DRAIN = false;
    bf16_t* yb; const int* list; const float* ewl;
    DEV void operator()(const f32x4 (&acc)[2][2][4][2], const pg8::Unit& u, int wr, int wc, int fr, int fq) const {
        int entv[2][4]; float wv[2][4];
#pragma unroll
        for (int ai = 0; ai < 2; ++ai)
#pragma unroll
            for (int m = 0; m < 4; ++m) { const int r = u.m0 + ai * 128 + wr * 64 + m * 16 + fr; const size_t q = (size_t)u.e * T + (r < u.c ? r : u.c - 1); entv[ai][m] = list[q]; wv[ai][m] = ewl[q]; }
#pragma unroll
        for (int ai = 0; ai < 2; ++ai)
#pragma unroll
            for (int m = 0; m < 4; ++m) {
                const int r = u.m0 + ai * 128 + wr * 64 + m * 16 + fr;
                if (r < u.c) {
                    const float w = wv[ai][m]; bf16_t* orow = yb + (size_t)entv[ai][m] * D + u.pn * 256 + wc * 32 + 4 * fq;
#pragma unroll
                    for (int bj = 0; bj < 2; ++bj)
#pragma unroll
                        for (int n = 0; n < 2; ++n) { const f32x4 v = acc[ai][bj][m][n] * w; u32x2 o; o.x = pk2(v[0], v[1]); o.y = pk2(v[2], v[3]); *(u32x2*)(orow + bj * 128 + n * 16) = o; }
                }
            }
    }
};
template <bool GATHER, class Epi> DEV void moe_gemm(const bf16_t* A, const bf16_t* Bt, int N, int K, const unsigned* cnt, const int* list, const Epi& E) {
    pg8::Gemm g{A, Bt, 0, N, K};
    moe_unit_table(cnt);
    MoeOrder<GATHER> S{__builtin_amdgcn_readfirstlane(*(const int*)(smem_all + LDS_MOE + 160 * 16)), (int)gridDim.x, (int)blockIdx.x, list};
    pg8::gemm_phase<Epi, MoeOrder<GATHER>, true, true>((PG8_LAS unsigned char*)smem_all, g, S, E);
}

template <class F> DEV void for_units(int n, int b0, int nb, F&& f) {
    const int rounds = (n + nb - 1) / nb;
    for (int k = 0; k < rounds; ++k) { int u = b0 + k * nb; if (u >= n) u = n - 1; f(u); }
}
#ifndef PROBE_DUP
#define PROBE_DUP 0u
#endif
#define PHASE_BEGIN(ph) if ((ph) >= ph_lo && (ph) < ph_hi) {
#define PHASE_END(ph) if ((ph) + 1 < ph_hi) xcd_barrier(bar); }
#define REPS(idx) for (int rep_ = 0; rep_ < ((((PROBE_DUP) >> (idx)) & 1u) ? 2 : 1); ++rep_)
#define ROWCTX const int tid_ = otid512(), lane = tid_ & 63, gw = blockIdx.x * 8 + (tid_ >> 6), nw = gridDim.x * 8;

__global__ void __launch_bounds__(512, 2) fwd(Params p, int ph_lo, int ph_hi) {
    unsigned char* ws = p.ws;
    const bool use_bar = (ph_hi - ph_lo) > 1;
    XcdBarrier bar; bar.bar = (unsigned*)(ws + OFF_CTL); bar.x = 0; bar.nloc = 0u; bar.nx = 0u;
    if (use_bar) bar = xcd_barrier_post((unsigned*)(ws + OFF_CTL));

    PHASE_BEGIN(0) REPS(31) phase_conv(p); PHASE_END(0)

#pragma unroll 1
    for (int l = 0; l < 2; ++l) {
        const int pb = 1 + l * NPL;
#define wl (ws + OFF_W + (size_t)l * W_LAYER)
#define HB ((bf16_t*)(ws + OFF_HB))
#define XB ((bf16_t*)(ws + OFF_X))
#define cnt ((unsigned*)(ws + OFF_CNT) + l * 1024)
#define list ((int*)(ws + OFF_LIST))
#define ew ((float*)(ws + OFF_EW))

        PHASE_BEGIN(pb + PL_INPROJ) REPS(PL_INPROJ)
        {
            Epi8InProj epi{EpiInProj{p.b_in + (size_t)l * PIN, (const float*)(ws + OFF_LBT) + l * D, ws}, (const float*)(ws + OFF_RSTD)};
            dense_gemm(XB, (const bf16_t*)(wl + W_IN), T, PIN, D, epi);
            Epi8MemKV ek{(bf16_t*)(ws + OFF_KC) + (size_t)l * TMEM * D, (bf16_t*)(ws + OFF_VCT) + (size_t)l * TMEM * D};
            if (gridDim.x == 256) {
                dense_gemm((const bf16_t*)(ws + OFF_MEMN), (const bf16_t*)(wl + W_CKV), TMEM, 2 * D, D, ek, 128, 64);
                if (blockIdx.x >= 192) conv_range(p, l, 1, CV_N1 - CV_INPROJ, CV_N1, 2 * ((int)blockIdx.x - 192) + vhalf(), 128);
            }
            else dense_gemm((const bf16_t*)(ws + OFF_MEMN), (const bf16_t*)(wl + W_CKV), TMEM, 2 * D, D, ek);
        }
        PHASE_END(pb + PL_INPROJ)

        PHASE_BEGIN(pb + PL_MIX) REPS(PL_MIX)
        {
            const int G = gridDim.x, bid = blockIdx.x, nh = G > 64 ? 64 : G;
            if (bid < nh) {
#pragma unroll 1
                for (int u = bid; u < 64; u += nh) hgrn_fused_block(p, l, u);
            }
            if (G <= 64 || bid >= 64) {
                const int b0 = G > 64 ? vbid() - 128 : vbid(), nb = G > 64 ? vgrid() - 128 : vgrid();
                if (vhalf() == 1) __syncthreads();
                for_units(2048, b0, nb, [&](int u) { swa_fast_unit(p, l, u); });
                if (vhalf() == 0) __syncthreads();
                conv_range(p, l, 1, 0, conv_mix_end(l), b0, nb);
                if (l == 0 && gridDim.x != 256) conv_layer(p, 1, 0, b0, nb);
            }
        }
        PHASE_END(pb + PL_MIX)

        PHASE_BEGIN(pb + PL_SUM) REPS(PL_SUM)
        {
            const bf16_t* MX = (const bf16_t*)(ws + OFF_MIXA); bf16_t* MS = (bf16_t*)(ws + OFF_Q1);
            ROWCTX
            for (int r0 = gw; r0 < T; r0 += 2 * nw) {
                u32x4 av[2][2], hv[2][2];
#pragma unroll
                for (int q = 0; q < 2; ++q) { const int r = r0 + q * nw < T ? r0 + q * nw : r0; const bf16_t* a = MX + (size_t)r * 2048 + 16 * lane;
                    av[q][0] = __builtin_nontemporal_load((const u32x4*)a); av[q][1] = __builtin_nontemporal_load((const u32x4*)(a + 8));
                    hv[q][0] = __builtin_nontemporal_load((const u32x4*)(a + 1024)); hv[q][1] = __builtin_nontemporal_load((const u32x4*)(a + 1032)); }
#pragma unroll
                for (int q = 0; q < 2; ++q) { const int r = r0 + q * nw < T ? r0 + q * nw : r0;
                    u32x4 o0, o1;
#pragma unroll
                    for (int i = 0; i < 4; ++i) { o0[i] = pk2(bflo(av[q][0][i]) + bflo(hv[q][0][i]), bfhi(av[q][0][i]) + bfhi(hv[q][0][i])); o1[i] = pk2(bflo(av[q][1][i]) + bflo(hv[q][1][i]), bfhi(av[q][1][i]) + bfhi(hv[q][1][i])); }
                    *(u32x4*)(MS + (size_t)r * 1024 + 16 * lane) = o0; *(u32x4*)(MS + (size_t)r * 1024 + 16 * lane + 8) = o1; }
            }
        }
        PHASE_END(pb + PL_SUM)

        PHASE_BEGIN(pb + PL_OUTPROJ) REPS(PL_OUTPROJ)
        {
            Epi8Resid epi{XB, HB, (float*)(ws + OFF_RSQ) + (size_t)(2 * l) * T * 16};
            dense_gemm((const bf16_t*)(ws + OFF_Q1), (const bf16_t*)(wl + W_OUT), T, D, D, epi);
        }
        PHASE_END(pb + PL_OUTPROJ)

        PHASE_BEGIN(pb + PL_CQ) REPS(PL_CQ)
        {
            Epi8ScaleBf16 epi{(bf16_t*)(ws + OFF_QC), 0.0625f, (const float*)(ws + OFF_RSQ) + (size_t)(2 * l) * T * 16};
            dense_gemm(HB, (const bf16_t*)(wl + W_CQ), T, D, D, epi);
        }
        PHASE_END(pb + PL_CQ)

        PHASE_BEGIN(pb + PL_XATTN) REPS(PL_XATTN)
        { if (vhalf() == 1) __syncthreads(); for_units(1024, vbid(), vgrid(), [&](int u) { xattn_fast_unit(p, l, u); }); if (vhalf() == 0) __syncthreads(); }
        PHASE_END(pb + PL_XATTN)

        PHASE_BEGIN(pb + PL_CO) REPS(PL_CO)
        {
            Epi8Resid epi{HB, HB, (float*)(ws + OFF_RSQ) + (size_t)(2 * l + 1) * T * 16};
            dense_gemm((const bf16_t*)(ws + OFF_OC), (const bf16_t*)(wl + W_CO), T, D, D, epi);
        }
        PHASE_END(pb + PL_CO)

        PHASE_BEGIN(pb + PL_ROUTER) REPS(PL_ROUTER)
        { router_phase(p, l, cnt, list, ew); }
        PHASE_END(pb + PL_ROUTER)

        PHASE_BEGIN(pb + PL_GATEUP) REPS(PL_GATEUP)
        {
            Epi8GateUp epi{(bf16_t*)(ws + OFF_ACT), (const float*)(ws + OFF_SRL)};
            moe_gemm<true>(HB, (const bf16_t*)(wl + W_GU), D, D, cnt, list, epi);
            if (l == 0 && gridDim.x == 256) conv_in_moe_tail(p, 1, 0, 0, 1216);
        }
        PHASE_END(pb + PL_GATEUP)

        PHASE_BEGIN(pb + PL_DOWN) REPS(PL_DOWN)
        {
            Epi8Down epi{(bf16_t*)(ws + OFF_YB), list, (const float*)(ws + OFF_EWL)};
            moe_gemm<false>((const bf16_t*)(ws + OFF_ACT), (const bf16_t*)(wl + W_DN), D, EFF, cnt, list, epi);
            if (l == 0 && gridDim.x == 256) conv_in_moe_tail(p, 1, 1, CV_N1 - CV_INPROJ - CV_DOWN, CV_N1 - CV_INPROJ);
        }
        PHASE_END(pb + PL_DOWN)

        PHASE_BEGIN(pb + PL_COMBINE) REPS(PL_COMBINE)
        {
            const bf16_t* YB = (const bf16_t*)(ws + OFF_YB);
            const float* gn = p.final_norm;
            ROWCTX
            for (int r0 = gw; r0 < T; r0 += 2 * nw) {
                u32x2 xr[2][4], ya[2][4], yb[2][4];
#pragma unroll
                for (int q = 0; q < 2; ++q) { const int r = r0 + q * nw < T ? r0 + q * nw : r0;
#pragma unroll
                    for (int i = 0; i < 4; ++i) { const int c = 4 * lane + 256 * i;
                        xr[q][i] = *(const u32x2*)(HB + (size_t)r * D + c);
                        ya[q][i] = __builtin_nontemporal_load((const u32x2*)(YB + (size_t)(2 * r) * D + c)); yb[q][i] = __builtin_nontemporal_load((const u32x2*)(YB + (size_t)(2 * r + 1) * D + c)); } }
#pragma unroll
                for (int q = 0; q < 2; ++q) { const int r = r0 + q * nw < T ? r0 + q * nw : r0;
                    float4 v[4]; float ss = 0.f;
#pragma unroll
                    for (int i = 0; i < 4; ++i) {
                        v[i].x = (bflo(xr[q][i].x) + bflo(ya[q][i].x)) + bflo(yb[q][i].x); v[i].y = (bfhi(xr[q][i].x) + bfhi(ya[q][i].x)) + bfhi(yb[q][i].x);
                        v[i].z = (bflo(xr[q][i].y) + bflo(ya[q][i].y)) + bflo(yb[q][i].y); v[i].w = (bfhi(xr[q][i].y) + bfhi(ya[q][i].y)) + bfhi(yb[q][i].y);
                        ss += v[i].x * v[i].x + v[i].y * v[i].y + v[i].z * v[i].z + v[i].w * v[i].w;
                    }
                    ss = wave_sum(ss);
                    const float rstd = rsqrtf(ss * (1.0f / D) + EPS);
#pragma unroll
                    for (int i = 0; i < 4; ++i) {
                        const int c = 4 * lane + 256 * i;
                        if (l == 0) {
                            u32x2 o; o.x = pk2(v[i].x, v[i].y); o.y = pk2(v[i].z, v[i].w); *(u32x2*)(XB + (size_t)r * D + c) = o;
                        } else {
                            const float4 gg = *(const float4*)(gn + c);
                            float4 o; o.x = v[i].x * rstd * gg.x; o.y = v[i].y * rstd * gg.y; o.z = v[i].z * rstd * gg.z; o.w = v[i].w * rstd * gg.w;
                            __builtin_nontemporal_store((f32x4){o.x, o.y, o.z, o.w}, (f32x4*)(p.out + (size_t)r * D + c));
                        }
                    }
                    if (l == 0 && lane == 0) ((float*)(ws + OFF_RSTD))[r] = rstd;
                }
            }
        }
        PHASE_END(pb + PL_COMBINE)
#undef wl
#undef HB
#undef XB
#undef cnt
#undef list
#undef ew
    }
}

extern "C" void kernel_launch(void* const* d_in, const int* in_sizes, int n_in, void* d_out, int out_size, void* d_ws, size_t ws_size, hipStream_t stream) {
    static int grid = 0;
    if (grid == 0) {
        if (n_in != 20 || ws_size < OFF_END) { fprintf(stderr, "kernel_launch: unexpected arguments (n_in %d, ws %zu, need %zu)\n", n_in, ws_size, (size_t)OFF_END); grid = -1; return; }
        int dev = 0, cus = 0, per_cu = 0;
        (void)hipGetDevice(&dev); (void)hipDeviceGetAttribute(&cus, hipDeviceAttributeMultiprocessorCount, dev);
        if (hipFuncSetAttribute((const void*)fwd, hipFuncAttributeMaxDynamicSharedMemorySize, LDS_BYTES) != hipSuccess) { fprintf(stderr, "kernel_launch: cannot raise the dynamic LDS limit\n"); grid = -1; return; }
        if (hipOccupancyMaxActiveBlocksPerMultiprocessor(&per_cu, (const void*)fwd, 512, LDS_BYTES) != hipSuccess || per_cu < 1) per_cu = 1;
        (void)hipGetLastError();
        grid = cus;
    }
    if (grid < 0) return;
    (void)hipMemsetAsync((char*)d_ws + OFF_CTL, 0, CTL_BYTES, stream);
    Params p{};
    const float** pp = (const float**)&p;
    for (int i = 0; i < 20; ++i) pp[i] = (const float*)d_in[i];
    p.out = (float*)d_out; p.ws = (unsigned char*)d_ws;
#if ONE_LAUNCH
    hipLaunchKernelGGL(fwd, dim3(grid), dim3(512), LDS_BYTES, stream, p, 0, NPH);
#else
    for (int ph = 0; ph < NPH; ++ph) hipLaunchKernelGGL(fwd, dim3(grid), dim3(512), LDS_BYTES, stream, p, ph, ph + 1);
#endif
}
```

```cpp
#include <hip/hip_runtime.h>
#include <cstdio>
#include <cstdint>

#define DBG_EMIT 4
#define DBG_PROBE_OFF ((size_t)700 * 1024 * 1024)
#define DBG_BUF OFF_GA
#ifndef FAST_HGRN
#define FAST_HGRN 1
#endif
#ifndef FAST_SWA
#define FAST_SWA 1
#endif
#ifndef FAST_XATTN
#define FAST_XATTN 1
#endif
#ifndef ONE_LAUNCH
#define ONE_LAUNCH 1
#endif

#define DEV __device__ __forceinline__

typedef unsigned short bf16_t;
typedef short bf16x8 __attribute__((ext_vector_type(8)));
typedef float f32x4 __attribute__((ext_vector_type(4)));
typedef unsigned u32x4 __attribute__((ext_vector_type(4)));
typedef unsigned u32x2 __attribute__((ext_vector_type(2)));
typedef float f32x16 __attribute__((ext_vector_type(16)));

constexpr int D = 1024, NB = 8, SEQ = 2048, T = NB * SEQ, MEM = 256, TMEM = NB * MEM;
constexpr int PIN = 7680, NEXP = 32, EFF = 512, NRL = 36;
constexpr float EPS = 1e-6f;

constexpr size_t MB = 1024 * 1024;
constexpr size_t OFF_CTL = 0;
constexpr size_t CTL_BYTES = 32768;
constexpr size_t OFF_CNT = 16384;
constexpr size_t OFF_LBT = CTL_BYTES;
constexpr size_t OFF_W = 1 * MB;
constexpr size_t W_IN = 0, W_OUT = W_IN + (size_t)PIN * D * 2, W_CQ = W_OUT + (size_t)2 * D * D * 2  , W_CKV = W_CQ + (size_t)D * D * 2,
                 W_CO = W_CKV + (size_t)2 * D * D * 2, W_R = W_CO + (size_t)D * D * 2, W_GU = W_R + (size_t)128 * D * 2,
                 W_DN = W_GU + (size_t)NEXP * D * D * 2, W_LAYER = W_DN + (size_t)NEXP * D * EFF * 2;
constexpr size_t OFF_MEMN = OFF_W + 2 * W_LAYER;
constexpr size_t OFF_KC = OFF_MEMN + (size_t)TMEM * D * 2;
constexpr size_t OFF_VCT = OFF_KC + 2 * (size_t)TMEM * D * 2;
constexpr size_t OFF_HB = OFF_VCT + 2 * (size_t)TMEM * D * 2;
constexpr size_t OFF_X = OFF_HB + (size_t)T * D * 2;
constexpr size_t SZ_B = (size_t)T * D * 2;
constexpr size_t OFF_QA = OFF_X + (size_t)T * D * 4;
constexpr size_t OFF_KA = OFF_QA + SZ_B;
constexpr size_t OFF_VAT = OFF_KA + SZ_B / 4;
constexpr size_t OFF_QH = OFF_VAT + SZ_B / 4;
constexpr size_t OFF_LOGF = OFF_QH + SZ_B;
constexpr size_t OFF_KH = OFF_LOGF + 2 * SZ_B;
constexpr size_t OFF_VHT = OFF_KH + SZ_B;
constexpr size_t OFF_OG = OFF_VHT + SZ_B;
constexpr size_t OFF_GA = OFF_OG + SZ_B;
constexpr size_t OFF_GH = OFF_GA + SZ_B;
constexpr size_t OFF_Q1 = OFF_GH + SZ_B;
constexpr size_t OFF_K2T = OFF_Q1 + SZ_B;
constexpr size_t OFF_AM = OFF_K2T + SZ_B;
constexpr size_t OFF_DD = OFF_AM + SZ_B / 4;
constexpr size_t OFF_MIXA = OFF_DD + 2 * MB;
constexpr size_t OFF_MIXH = OFF_MIXA + SZ_B;
constexpr size_t OFF_EW = OFF_MIXH + SZ_B;
constexpr size_t OFF_LIST = OFF_EW + (size_t)T * 2 * 4;
constexpr size_t OFF_RSQ = OFF_LIST + (size_t)NEXP * T * 4;
constexpr size_t OFF_SRL = OFF_RSQ + (size_t)4 * T * 16 * 4;
constexpr size_t OFF_EWL = OFF_SRL + (size_t)NEXP * T * 4;
constexpr size_t OFF_RSTD = OFF_EWL + (size_t)NEXP * T * 4;
constexpr size_t OFF_END = OFF_RSTD + (size_t)T * 4;
constexpr size_t OFF_QC = OFF_QH, OFF_OC = OFF_KH, OFF_ACT = OFF_LOGF, OFF_YB = OFF_OG;

struct Params {
    const float *x, *mem, *mix_norm, *w_in, *b_in, *attn_sinks, *hg_lb_logits, *hg_out_norm, *w_out, *cross_norm, *mem_norm,
                *w_cq, *w_ckv, *w_co, *ffn_norm, *w_router, *b_router, *w_gate_up, *w_down, *final_norm;
    float* out;
    unsigned char* ws;
};

typedef __bf16 bf16x2_t __attribute__((ext_vector_type(2)));
DEV unsigned pk2(float lo, float hi) { bf16x2_t v = {(__bf16)lo, (__bf16)hi}; return __builtin_bit_cast(unsigned, v); }
DEV bf16_t f2bf(float x) { return __builtin_bit_cast(unsigned short, (__bf16)x); }
DEV bf16x8 pack8(const f32x16& x, int s) {
    u32x4 w; w.x = pk2(x[8 * s + 0], x[8 * s + 1]); w.y = pk2(x[8 * s + 2], x[8 * s + 3]); w.z = pk2(x[8 * s + 4], x[8 * s + 5]); w.w = pk2(x[8 * s + 6], x[8 * s + 7]);
    return __builtin_bit_cast(bf16x8, w);
}
DEV float bf2f(bf16_t h) { return __uint_as_float((unsigned)h << 16); }
DEV float bflo(unsigned u) { return __uint_as_float(u << 16); }
DEV float bfhi(unsigned u) { return __uint_as_float(u & 0xffff0000u); }
DEV float fexp(float x) { return __builtin_amdgcn_exp2f(x * 1.44269504089f); }
DEV float flog(float x) { return __builtin_amdgcn_logf(x) * 0.69314718056f; }
DEV float frcp(float x) { return __builtin_amdgcn_rcpf(x); }
DEV float fsigmoid(float x) { return frcp(1.0f + fexp(-x)); }
DEV float fsilu(float x) { return x * fsigmoid(x); }
DEV int perm16(int i) { return ((i >> 2) & 1) * 8 + ((i >> 3) & 1) * 4 + (i & 3); }
DEV int otid() { int t = threadIdx.x & 255; asm volatile("" : "+v"(t)); return t; }
DEV int otid512() { int t = threadIdx.x; asm volatile("" : "+v"(t)); return t; }
DEV float ld_rsq(const float* p) {
    const f32x4 a = *(const f32x4*)p, b = *(const f32x4*)(p + 4), c = *(const f32x4*)(p + 8), d = *(const f32x4*)(p + 12);
    return ((a[0] + a[1]) + (a[2] + a[3])) + ((b[0] + b[1]) + (b[2] + b[3])) + (((c[0] + c[1]) + (c[2] + c[3])) + ((d[0] + d[1]) + (d[2] + d[3])));
}
DEV float wave_sum(float v) {
    v += __shfl_xor(v, 32); v += __shfl_xor(v, 16); v += __shfl_xor(v, 8); v += __shfl_xor(v, 4); v += __shfl_xor(v, 2); v += __shfl_xor(v, 1); return v;
}
DEV float wave_max(float v) {
    v = fmaxf(v, __shfl_xor(v, 32)); v = fmaxf(v, __shfl_xor(v, 16)); v = fmaxf(v, __shfl_xor(v, 8)); v = fmaxf(v, __shfl_xor(v, 4)); v = fmaxf(v, __shfl_xor(v, 2)); v = fmaxf(v, __shfl_xor(v, 1)); return v;
}

#define XB_TMO      128
#define XB_XCNT(j)  (256  + 64 * (j))
#define XB_XSUB(j)  (1280 + 64 * (j))
#define XB_XGEN(j)  (2304 + 64 * (j))
#define XB_TOP      3328
#define XB_TOPGEN   3392
#define XCD_BAR_WORDS 3456
#define XB_SPIN_CAP (1u << 18)
#define LAS __attribute__((address_space(3)))

__device__ __forceinline__ unsigned xb_ld(unsigned* p)              { return __hip_atomic_load(p, __ATOMIC_RELAXED, __HIP_MEMORY_SCOPE_AGENT); }
__device__ __forceinline__ unsigned xb_add(unsigned* p, unsigned v) { return __hip_atomic_fetch_add(p, v, __ATOMIC_RELAXED, __HIP_MEMORY_SCOPE_AGENT); }
__device__ __forceinline__ unsigned xb_xcc_id() { return (unsigned)__builtin_amdgcn_s_getreg((3 << 11) | 20) & 0xFu; }
#define XB_SPIN(cond, bar) do { unsigned _sp = 0; while (cond) { __builtin_amdgcn_s_sleep(1); \
    if ((++_sp & 255u) == 0u) { if (xb_ld(&(bar)[XB_TMO])) break; if (_sp > XB_SPIN_CAP) { atomicAdd(&(bar)[XB_TMO], 1u); break; } } } } while (0)

extern __shared__ __attribute__((aligned(16))) unsigned char smem_all[];
struct XcdBarrier { unsigned* bar; unsigned x; unsigned nloc, nx; };

__device__ __forceinline__ XcdBarrier xcd_barrier_post(unsigned* bar) {
    XcdBarrier b; b.bar = bar; b.x = xb_xcc_id(); b.nloc = 0u; b.nx = 0u;
    if (threadIdx.x == 0) { (void)xb_add(&bar[XB_XCNT(b.x)], 1u); volatile unsigned* cen = (volatile unsigned*)(smem_all + 131072 + 3072); cen[0] = 0u; cen[1] = 0u; }
    return b;
}
__device__ __forceinline__ void xcd_barrier_complete(unsigned* bar, unsigned x, unsigned& nloc, unsigned& nx) {
    const unsigned G = gridDim.x * gridDim.y * gridDim.z;
    unsigned sum, cnt, mine, sp = 0u;
    for (;;) {
        sum = 0u; cnt = 0u; mine = 0u;
#pragma unroll
        for (unsigned j = 0; j < 16; ++j) { const unsigned c = xb_ld(&bar[XB_XCNT(j)]); sum += c; cnt += (c > 0u) ? 1u : 0u; mine = (j == x) ? c : mine; }
        if (sum == G) break;
        __builtin_amdgcn_s_sleep(1);
        if ((++sp & 255u) == 0u) { if (xb_ld(&bar[XB_TMO])) break; if (sp > XB_SPIN_CAP) { atomicAdd(&bar[XB_TMO], 1u); break; } }
    }
    nloc = mine > 0u ? mine : 1u; nx = cnt > 0u ? cnt : 1u;
}
__device__ __forceinline__ void xcd_barrier(XcdBarrier& b) {
    asm volatile("s_waitcnt vmcnt(0)" ::: "memory");
    __syncthreads();
    if (threadIdx.x == 0) {
        unsigned* bar = b.bar;
        __builtin_amdgcn_s_waitcnt(0);
        volatile unsigned* cen = (volatile unsigned*)(smem_all + 131072 + 3072);
        unsigned nloc = cen[0], nx = cen[1];
        if (nloc == 0u) { xcd_barrier_complete(bar, b.x, nloc, nx); cen[0] = nloc; cen[1] = nx; }
        const unsigned old = xb_add(&bar[XB_XSUB(b.x)], 1u);
        const unsigned gen = old / nloc;
        if (old + 1u == (gen + 1u) * nloc) {
            __builtin_amdgcn_fence(__ATOMIC_RELEASE, "agent");
            asm volatile("s_waitcnt vmcnt(0)" ::: "memory");
            const unsigned og = xb_add(&bar[XB_TOP], 1u);
            const unsigned tg = og / nx;
            if (og + 1u == (tg + 1u) * nx) xb_add(&bar[XB_TOPGEN], 1u);
            else XB_SPIN(xb_ld(&bar[XB_TOPGEN]) == tg, bar);
            __builtin_amdgcn_fence(__ATOMIC_ACQUIRE, "agent");
            xb_add(&bar[XB_XGEN(b.x)], 1u);
            asm volatile("s_waitcnt vmcnt(0)" ::: "memory");
        } else {
            XB_SPIN(xb_ld(&bar[XB_XGEN(b.x)]) == gen, bar);
            __builtin_amdgcn_fence(__ATOMIC_ACQUIRE, "agent");
            asm volatile("s_waitcnt vmcnt(0)" ::: "memory");
        }
    }
    __syncthreads();
}

constexpr int LDS_BYTES = 131072 + 4096;
constexpr int LDS_MOE = 131072;
extern __shared__ __attribute__((aligned(16))) unsigned char smem_all[];
#define smem (smem_all + ((threadIdx.x >> 8) << 16))
DEV int vhalf() { return __builtin_amdgcn_readfirstlane((int)(threadIdx.x >> 8)); }
DEV int vbid() { return (int)blockIdx.x * 2 + vhalf(); }
DEV int vgrid() { return (int)gridDim.x * 2; }

DEV int gu_perm(int n) { return n < 512 ? ((n >> 4) * 32 + (n & 15)) : (((n - 512) >> 4) * 32 + 16 + ((n - 512) & 15)); }

DEV int win_perm(int n) {
    if (n >= 4608 && n < 5632) { const int hd = (n - 4608) >> 7, c = (n - 4608) & 127; return (hd < 4 ? 4608 + 256 * hd : 6656 + 256 * (hd - 4)) + c; }
    if (n >= 6656) { const int hd = (n - 6656) >> 7, c = (n - 6656) & 127; return (hd < 4 ? 4608 + 256 * hd : 6656 + 256 * (hd - 4)) + 128 + c; }
    return n;
}
struct ConvTile { const float* src; bf16_t* dst; int K, N, k0, n0; bool perm; const float* gk; int ldd; bool dup; bool wperm; };
DEV void conv_load(const ConvTile& c, float4 (&v)[8], int tid) {
#pragma unroll
    for (int j = 0; j < 8; ++j) { const f32x4 t = __builtin_nontemporal_load((const f32x4*)(c.src + (size_t)(c.k0 + 8 * (tid >> 4) + j) * c.N + c.n0 + 4 * (tid & 15)));
        v[j] = make_float4(t[0], t[1], t[2], t[3]); }
}
DEV void conv_pack(const ConvTile& c, const float4 (&v)[8], u32x4 (&w)[4], int tid) {
    const int kk = c.k0 + 8 * (tid >> 4);
    float g8[8];
#pragma unroll
    for (int j = 0; j < 8; ++j) g8[j] = c.gk ? c.gk[kk + j] : 1.0f;
#pragma unroll
    for (int i = 0; i < 4; ++i) {
        w[i].x = pk2((i == 0 ? v[0].x : i == 1 ? v[0].y : i == 2 ? v[0].z : v[0].w) * g8[0], (i == 0 ? v[1].x : i == 1 ? v[1].y : i == 2 ? v[1].z : v[1].w) * g8[1]);
        w[i].y = pk2((i == 0 ? v[2].x : i == 1 ? v[2].y : i == 2 ? v[2].z : v[2].w) * g8[2], (i == 0 ? v[3].x : i == 1 ? v[3].y : i == 2 ? v[3].z : v[3].w) * g8[3]);
        w[i].z = pk2((i == 0 ? v[4].x : i == 1 ? v[4].y : i == 2 ? v[4].z : v[4].w) * g8[4], (i == 0 ? v[5].x : i == 1 ? v[5].y : i == 2 ? v[5].z : v[5].w) * g8[5]);
        w[i].w = pk2((i == 0 ? v[6].x : i == 1 ? v[6].y : i == 2 ? v[6].z : v[6].w) * g8[6], (i == 0 ? v[7].x : i == 1 ? v[7].y : i == 2 ? v[7].z : v[7].w) * g8[7]);
    }
}
DEV void conv_store(const ConvTile& c, const u32x4 (&w)[4], int tid) {
    const int kk = c.k0 + 8 * (tid >> 4);
#pragma unroll
    for (int i = 0; i < 4; ++i) {
        const int n = c.n0 + 4 * (tid & 15) + i, drow = c.perm ? gu_perm(n) : (c.wperm ? win_perm(n) : n);
        *(u32x4*)(c.dst + (size_t)drow * c.ldd + kk) = w[i];
        if (c.dup) *(u32x4*)(c.dst + (size_t)drow * c.ldd + c.K + kk) = w[i];
    }
}

DEV void rownorm_to_bf16(const float* __restrict__ src, const float* __restrict__ g, bf16_t* __restrict__ dst, int lane, bf16_t* __restrict__ raw = nullptr) {
    float4 v[4]; float ss = 0.f;
#pragma unroll
    for (int i = 0; i < 4; ++i) { v[i] = *(const float4*)(src + 4 * lane + 256 * i); ss += v[i].x * v[i].x + v[i].y * v[i].y + v[i].z * v[i].z + v[i].w * v[i].w; }
    ss = wave_sum(ss);
    const float rstd = rsqrtf(ss * (1.0f / D) + EPS);
#pragma unroll
    for (int i = 0; i < 4; ++i) {
        const float4 gg = *(const float4*)(g + 4 * lane + 256 * i);
        u32x2 o; o.x = pk2(v[i].x * rstd * gg.x, v[i].y * rstd * gg.y); o.y = pk2(v[i].z * rstd * gg.z, v[i].w * rstd * gg.w);
        *(u32x2*)(dst + 4 * lane + 256 * i) = o;
        if (raw) { u32x2 q; q.x = pk2(v[i].x, v[i].y); q.y = pk2(v[i].z, v[i].w); *(u32x2*)(raw + 4 * lane + 256 * i) = q; }
    }
}

DEV ConvTile conv_describe(const Params& p, int l, int t) {
    constexpr int J0 = 960, J1 = J0 + 128, J2 = J1 + 128, J3 = J2 + 256, J4 = J3 + 128, J5 = J4 + 4096;
    unsigned char* wl = p.ws + OFF_W + (size_t)l * W_LAYER;
    ConvTile c; c.perm = false; c.gk = nullptr; c.dup = false; c.wperm = false; int ti;
#define CB asm volatile("" ::: "memory");
    if (t < J0) { CB c.src = p.w_in + (size_t)l * D * PIN; c.dst = (bf16_t*)(wl + W_IN); c.K = D; c.N = PIN; ti = t; c.wperm = true; c.gk = p.mix_norm + l * D; }
    else if (t < J1) { CB c.src = p.w_out + (size_t)l * D * D; c.dst = (bf16_t*)(wl + W_OUT); c.K = D; c.N = D; ti = t - J0; }
    else if (t < J2) { CB c.src = p.w_cq + (size_t)l * D * D; c.dst = (bf16_t*)(wl + W_CQ); c.K = D; c.N = D; ti = t - J1; c.gk = p.cross_norm + l * D; }
    else if (t < J3) { CB c.src = p.w_ckv + (size_t)l * D * 2 * D; c.dst = (bf16_t*)(wl + W_CKV); c.K = D; c.N = 2 * D; ti = t - J2; }
    else if (t < J4) { CB c.src = p.w_co + (size_t)l * D * D; c.dst = (bf16_t*)(wl + W_CO); c.K = D; c.N = D; ti = t - J3; }
    else if (t < J5) { CB const int e = (t - J4) >> 7; c.src = p.w_gate_up + ((size_t)l * NEXP + e) * D * D; c.dst = (bf16_t*)(wl + W_GU) + (size_t)e * D * D; c.K = D; c.N = D; c.perm = true; ti = (t - J4) & 127; c.gk = p.ffn_norm + l * D; }
    else { CB const int e = (t - J5) >> 6; c.src = p.w_down + ((size_t)l * NEXP + e) * EFF * D; c.dst = (bf16_t*)(wl + W_DN) + (size_t)e * D * EFF; c.K = EFF; c.N = D; ti = (t - J5) & 63; }
#undef CB
    const int tn = c.N >> 6; c.k0 = (ti / tn) * 128; c.n0 = (ti % tn) * 64; c.ldd = c.dup ? 2 * c.K : c.K;
    return c;
}
DEV int conv_pick(int sel, int idx) { return sel == 0 ? (idx < 960 ? idx : idx + 256) : (idx < 256 ? 960 + idx : idx + 1216); }
DEV void conv_range(const Params& p, int l, int sel, int t0, int t1, int b0, int nb) {
    const int n = t1 - t0, rounds = (n + nb - 1) / nb;
    if (n <= 0) return;
    const int tid = otid();
    auto tix = [&](int k) { if (k >= rounds) k = rounds - 1; int t = b0 + k * nb; return conv_pick(sel, t0 + (t < n ? t : n - 1)); };
    ConvTile ca = conv_describe(p, l, tix(0)), cb = conv_describe(p, l, tix(1)); float4 va[8]; u32x4 wa[4];
    conv_load(ca, va, tid);
    for (int k = 0; k < rounds; k += 2) {
        conv_pack(ca, va, wa, tid);
        cb = conv_describe(p, l, tix(k + 1)); conv_load(cb, va, tid);
        conv_store(ca, wa, tid);
        if (k + 1 < rounds) {
            conv_pack(cb, va, wa, tid);
            ca = conv_describe(p, l, tix(k + 2)); conv_load(ca, va, tid);
            conv_store(cb, wa, tid);
        }
    }
}
DEV void conv_layer(const Params& p, int l, int sel, int b0, int nb) { conv_range(p, l, sel, 0, sel == 0 ? 1216 : 6528, b0, nb); }
constexpr int CV_N1 = 6528, CV_INPROJ = 576, CV_DOWN = 700;
DEV int conv_mix_end(int l) { return (int)gridDim.x == 256 ? CV_N1 - CV_INPROJ - (l == 1 ? CV_DOWN : 0) : CV_N1; }
DEV void conv_in_moe_tail(const Params& p, int l, int sel, int t0, int t1) {
    const int NU = 4 * __builtin_amdgcn_readfirstlane(*(const int*)(smem_all + LDS_MOE + 160 * 16)), G = (int)gridDim.x, c = (int)blockIdx.x;
    const int R = (NU + G - 1) / G, nfull = NU > 0 ? NU - (R - 1) * G : 0, idle = G - nfull;
    if (idle >= 32) { if (c >= nfull) conv_range(p, l, sel, t0, t1, 2 * (c - nfull) + vhalf(), 2 * idle); }
    else conv_range(p, l, sel, t0, t1, vbid(), vgrid());
}
DEV void phase_conv(const Params& p) {
    const int G = vgrid(), bid = vbid(), tid = threadIdx.x & 255;
    unsigned char* ws = p.ws;
    conv_layer(p, 0, 0, bid, G);
    for (int idx = bid * 256 + tid; idx < 2 * 128 * D; idx += G * 256) {
        const int l = idx / (128 * D), r = idx % (128 * D), n = r / D, k = r % D;
        const float v = n < NRL ? p.w_router[(size_t)l * D * NRL + (size_t)k * NRL + n] * p.ffn_norm[l * D + k] : 0.f;
        ((bf16_t*)(ws + OFF_W + (size_t)l * W_LAYER + W_R))[r] = f2bf(v);
    }
    if (bid == 0 && tid < 128) ((unsigned*)(ws + OFF_CNT))[tid] = 0u;
    for (int idx = bid * 256 + tid; idx < D; idx += G * 256) {
        float* lbt = (float*)(ws + OFF_LBT);
        const float l0 = p.hg_lb_logits[idx], l1 = p.hg_lb_logits[D + idx];
        lbt[idx] = 0.f; lbt[D + idx] = 1.0f / (1.0f + expf(l0 - l1));
    }
    const int lane = tid & 63, gw = bid * 4 + (tid >> 6), nw = G * 4;
    for (int r = gw; r < TMEM + T; r += nw) {
        if (r < TMEM) rownorm_to_bf16(p.mem + (size_t)r * D, p.mem_norm, (bf16_t*)(ws + OFF_MEMN) + (size_t)r * D, lane);
        else {
            const int t = r - TMEM; const float* src = p.x + (size_t)t * D; bf16_t* raw = (bf16_t*)(ws + OFF_X) + (size_t)t * D;
            float4 v[4]; float ss = 0.f;
#pragma unroll
            for (int i = 0; i < 4; ++i) { v[i] = *(const float4*)(src + 4 * lane + 256 * i); ss += v[i].x * v[i].x + v[i].y * v[i].y + v[i].z * v[i].z + v[i].w * v[i].w; }
            ss = wave_sum(ss);
#pragma unroll
            for (int i = 0; i < 4; ++i) { u32x2 q; q.x = pk2(v[i].x, v[i].y); q.y = pk2(v[i].z, v[i].w); *(u32x2*)(raw + 4 * lane + 256 * i) = q; }
            if (lane == 0) ((float*)(ws + OFF_RSTD))[t] = rsqrtf(ss * (1.0f / D) + EPS);
        }
    }
}

struct ARows {
    const bf16_t* A; int lda;
    const int* list;
    int nvalid;
    int rowoff;
    const bf16_t* A2; int ksplit;
};
template <class Epi>
DEV void gemm_tile(const ARows& ar, const bf16_t* __restrict__ Bt, int ldb, int K, int m0, int n0, Epi& epi) {
    const int tid = otid(), lane = tid & 63, wid = tid >> 6, wr = wid >> 1, wc = wid & 1, fr = lane & 15, fq = lane >> 4;
    const int srow = tid >> 3, sc = (tid & 7) ^ ((tid >> 4) & 7);
    const bf16_t* ap[4]; const bf16_t* bp[4];
#pragma unroll
    for (int i = 0; i < 4; ++i) {
        int r = m0 + srow + 32 * i; if (r >= ar.nvalid) r = ar.nvalid - 1;
        const size_t arow = ar.list ? (size_t)(ar.list[r] >> 1) : (size_t)(ar.rowoff + r);
        ap[i] = ar.A + arow * ar.lda + sc * 8;
        bp[i] = Bt + (size_t)(n0 + srow + 32 * i) * ldb + sc * 8;
    }
    const long a2d = ar.A2 ? (long)(ar.A2 - ar.A) - (long)ar.ksplit * 64 : 0;
    const int ks = ar.A2 ? ar.ksplit : (1 << 30);
    f32x4 acc[4][4];
#pragma unroll
    for (int mi = 0; mi < 4; ++mi)
#pragma unroll
        for (int ni = 0; ni < 4; ++ni) acc[mi][ni] = (f32x4){0.f, 0.f, 0.f, 0.f};
    const int nk = K >> 6;
    __syncthreads();
    auto stage = [&](int kt, int buf) {
        unsigned char* sa = smem + buf * 32768 + tid * 16;
#pragma unroll
        for (int i = 0; i < 4; ++i) {
            __builtin_amdgcn_global_load_lds((const unsigned*)(ap[i] + kt * 64 + (kt >= ks ? a2d : 0)), (unsigned*)(sa + i * 4096), 16, 0, 0);
            __builtin_amdgcn_global_load_lds((const unsigned*)(bp[i] + (kt >= ks ? kt - ks : kt) * 64), (unsigned*)(sa + 16384 + i * 4096), 16, 0, 0);
        }
    };
    stage(0, 0);
    const int aoff = (wr * 64 + fr) * 128, boff = 16384 + (wc * 64 + fr) * 128, sw = (fr >> 1) & 7;
    for (int kt = 0; kt < nk; ++kt) {
        asm volatile("s_waitcnt vmcnt(0)" ::: "memory");
        __syncthreads();
        if (kt + 1 < nk) stage(kt + 1, (kt + 1) & 1);
        const unsigned char* sb = smem + (kt & 1) * 32768;
#pragma unroll
        for (int kk = 0; kk < 2; ++kk) {
            const int co = ((kk * 4 + fq) ^ sw) * 16;
            bf16x8 af[4], bfr[4];
#pragma unroll
            for (int i = 0; i < 4; ++i) { af[i] = *(const bf16x8*)(sb + aoff + i * 2048 + co); bfr[i] = *(const bf16x8*)(sb + boff + i * 2048 + co); }
#pragma unroll
            for (int mi = 0; mi < 4; ++mi)
#pragma unroll
                for (int ni = 0; ni < 4; ++ni) acc[mi][ni] = __builtin_amdgcn_mfma_f32_16x16x32_bf16(bfr[ni], af[mi], acc[mi][ni], 0, 0, 0);
        }
    }
    epi(acc, m0, n0, wr, wc, fr, fq);
}

template <class F> DEV void for_tiles(int TMt, int TNt, int SM, int SN, F&& f) {
    const int G = vgrid(), vb = vbid(), nt = TMt * TNt;
    if ((G & 15) == 0 && (TMt % SM) == 0 && (TNt % SN) == 0 && SM * SN == (G >> 3)) {
        const int xcd = (vb >> 1) & 7, loc = ((vb >> 4) << 1) | (vb & 1), nsn = TNt / SN, nsup = (TMt / SM) * nsn, rounds = (nsup + 7) >> 3;
        for (int k = 0; k < rounds; ++k) { const int sup = xcd + 8 * k; if (sup >= nsup) break;
            f((sup / nsn) * SM + loc / SN, (sup % nsn) * SN + loc % SN); }
    } else {
        const int rounds = (nt + G - 1) / G;
        for (int k = 0; k < rounds; ++k) { int t = vb + k * G; if (t >= nt) t = nt - 1; f(t / TNt, t % TNt); }
    }
}

struct EpiInProj {
    const float* bias; const float* lbt; unsigned char* ws;
    static DEV void segment(int n0, int& seg, int& sb) {
        if (n0 < 1024) { seg = 0; sb = 0; } else if (n0 < 1280) { seg = 1; sb = 1024; } else if (n0 < 1536) { seg = 2; sb = 1280; }
        else if (n0 < 2560) { seg = 3; sb = 1536; } else if (n0 < 3584) { seg = 4; sb = 2560; } else if (n0 < 4608) { seg = 5; sb = 3584; }
        else if (n0 < 5632) { seg = 6; sb = 4608; } else if (n0 < 6656) { seg = 7; sb = 5632; } else { seg = 8; sb = 6656; }
    }
    DEV void operator()(f32x4 (&acc)[4][4], int m0, int n0, int wr, int wc, int fr, int fq) const {
        int seg, sb; segment(n0, seg, sb);
#pragma unroll
        for (int mi = 0; mi < 4; ++mi)
#pragma unroll
            for (int ni = 0; ni < 4; ++ni) { const int n = n0 + wc * 64 + ni * 16 + 4 * fq;
                put(seg, sb, m0 + wr * 64 + mi * 16 + fr, n, acc[mi][ni], *(const f32x4*)(bias + n), *(const f32x4*)(lbt + ((n - sb) & 1023))); }
    }
    DEV void put8(int seg, int sb, int m, int n, const f32x4& a0, const f32x4& a1, const f32x4& b0, const f32x4& b1, const f32x4& l0, const f32x4& l1) const {
        if (seg == 2 || seg == 5) { put(seg, sb, m, n, a0, b0, l0); put(seg, sb, m, n + 4, a1, b1, l1); return; }
        const int c = n - sb; const f32x4 v0 = a0 + b0, v1 = a1 + b1;
        if (seg == 0) { u32x4 o; o.x = pk2(v0[0] * 0.125f, v0[1] * 0.125f); o.y = pk2(v0[2] * 0.125f, v0[3] * 0.125f); o.z = pk2(v1[0] * 0.125f, v1[1] * 0.125f); o.w = pk2(v1[2] * 0.125f, v1[3] * 0.125f);
            *(u32x4*)((bf16_t*)(ws + OFF_QA) + (size_t)m * 1024 + c) = o; }
        else if (seg == 1) { u32x4 o; o.x = pk2(v0[0], v0[1]); o.y = pk2(v0[2], v0[3]); o.z = pk2(v1[0], v1[1]); o.w = pk2(v1[2], v1[3]); *(u32x4*)((bf16_t*)(ws + OFF_KA) + (size_t)m * 256 + c) = o; }
        else if (seg == 3) { u32x4 o; o.x = pk2(fsilu(v0[0]), fsilu(v0[1])); o.y = pk2(fsilu(v0[2]), fsilu(v0[3])); o.z = pk2(fsilu(v1[0]), fsilu(v1[1])); o.w = pk2(fsilu(v1[2]), fsilu(v1[3]));
            *(u32x4*)((bf16_t*)(ws + OFF_QH) + (size_t)m * 1024 + c) = o; }
        else if (seg == 4) {
            typedef _Float16 h16x8 __attribute__((ext_vector_type(8))); h16x8 lf;
#pragma unroll
            for (int j = 0; j < 4; ++j) {
                { const float e = fexp(-v0[j]), sg = frcp(1.0f + e), f = l0[j] + (1.0f - l0[j]) * sg; lf[j] = (_Float16)flog(fmaxf(f, 1e-30f)); }
                { const float e = fexp(-v1[j]), sg = frcp(1.0f + e), f = l1[j] + (1.0f - l1[j]) * sg; lf[4 + j] = (_Float16)flog(fmaxf(f, 1e-30f)); }
            }
            *(h16x8*)((_Float16*)(ws + OFF_LOGF) + (size_t)m * 1024 + c) = lf;
        }
        else { u32x4 o; o.x = pk2(fsigmoid(v0[0]), fsigmoid(v0[1])); o.y = pk2(fsigmoid(v0[2]), fsigmoid(v0[3])); o.z = pk2(fsigmoid(v1[0]), fsigmoid(v1[1])); o.w = pk2(fsigmoid(v1[2]), fsigmoid(v1[3]));
            *(u32x4*)((bf16_t*)(ws + OFF_GA) + (size_t)m * 1024 + c) = o; }
    }
    DEV void put(int seg, int sb, int m, int n, const f32x4& a, const f32x4& bv, const f32x4& lb) const {
            {
                const int c = n - sb;
                const f32x4 v = a + bv;
                const int b = m >> 11, s = m & 2047;
                if (seg == 0) { u32x2 o; o.x = pk2(v[0] * 0.125f, v[1] * 0.125f); o.y = pk2(v[2] * 0.125f, v[3] * 0.125f); *(u32x2*)((bf16_t*)(ws + OFF_QA) + (size_t)m * 1024 + c) = o; }
                else if (seg == 1) { u32x2 o; o.x = pk2(v[0], v[1]); o.y = pk2(v[2], v[3]); *(u32x2*)((bf16_t*)(ws + OFF_KA) + (size_t)m * 256 + c) = o; }
                else if (seg == 2) { bf16_t* d = (bf16_t*)(ws + OFF_VAT) + ((size_t)(b * 4 + (c >> 6)) * 64 + (c & 63)) * 2048 + ((s & ~15) | perm16(s & 15));
#pragma unroll
                    for (int j = 0; j < 4; ++j) d[(size_t)j * 2048] = f2bf(v[j]); }
                else if (seg == 3) { u32x2 o; o.x = pk2(fsilu(v[0]), fsilu(v[1])); o.y = pk2(fsilu(v[2]), fsilu(v[3])); *(u32x2*)((bf16_t*)(ws + OFF_QH) + (size_t)m * 1024 + c) = o; }
                else if (seg == 4) {
                    f32x4 lf; float kh[4];
#pragma unroll
                    for (int j = 0; j < 4; ++j) { const float e = fexp(-v[j]); const float sg = frcp(1.0f + e), sn = e * sg;
                        const float f = lb[j] + (1.0f - lb[j]) * sg; lf[j] = flog(fmaxf(f, 1e-30f)); kh[j] = (1.0f - lb[j]) * sn; }
                    typedef _Float16 h16x4 __attribute__((ext_vector_type(4)));
                    *(h16x4*)((_Float16*)(ws + OFF_LOGF) + (size_t)m * 1024 + c) = (h16x4){(_Float16)lf[0], (_Float16)lf[1], (_Float16)lf[2], (_Float16)lf[3]};
                }
                else if (seg == 5) { bf16_t* d = (bf16_t*)(ws + OFF_VHT) + ((size_t)(b * 8 + (c >> 7)) * 128 + (c & 127)) * 2048 + s;
#pragma unroll
                    for (int j = 0; j < 4; ++j) d[(size_t)j * 2048] = f2bf(v[j]); }
                else if (seg == 6) { u32x2 o; o.x = pk2(fsilu(v[0]), fsilu(v[1])); o.y = pk2(fsilu(v[2]), fsilu(v[3])); *(u32x2*)((bf16_t*)(ws + OFF_OG) + (size_t)m * 1024 + c) = o; }
                else { u32x2 o; o.x = pk2(fsigmoid(v[0]), fsigmoid(v[1])); o.y = pk2(fsigmoid(v[2]), fsigmoid(v[3]));
                    *(u32x2*)((bf16_t*)(ws + (seg == 7 ? OFF_GA : OFF_GH)) + (size_t)m * 1024 + c) = o; }
            }
    }
};
struct EpiMemKV {
    bf16_t* kc; bf16_t* vct;
    DEV void operator()(f32x4 (&acc)[4][4], int m0, int n0, int wr, int wc, int fr, int fq) const {
#pragma unroll
        for (int mi = 0; mi < 4; ++mi)
#pragma unroll
            for (int ni = 0; ni < 4; ++ni) {
                const int m = m0 + wr * 64 + mi * 16 + fr, n = n0 + wc * 64 + ni * 16 + 4 * fq;
                const int b = m >> 8, mm = m & 255; const f32x4 v = acc[mi][ni];
                if (n < 1024) { const int hx = n >> 8, d = n & 255; u32x2 o; o.x = pk2(v[0], v[1]); o.y = pk2(v[2], v[3]);
                    *(u32x2*)(kc + ((size_t)(b * 4 + hx) * 256 + mm) * 256 + d) = o; }
                else { const int nn = n - 1024, hx = nn >> 8, d = nn & 255; bf16_t* dp = vct + ((size_t)(b * 4 + hx) * 256 + d) * 256 + ((mm & ~31) | (8 * ((mm & 15) >> 2) + 4 * ((mm >> 4) & 1) + (mm & 3)));
#pragma unroll
                    for (int j = 0; j < 4; ++j) dp[j * 256] = f2bf(v[j]); }
            }
    }
};
struct EpiResid {
    const float* base; float* out; bf16_t* xb; float* rsq;
    DEV void operator()(f32x4 (&acc)[4][4], int m0, int n0, int wr, int wc, int fr, int fq) const {
#pragma unroll
        for (int mi = 0; mi < 4; ++mi) {
            float ss = 0.f; const int m = m0 + wr * 64 + mi * 16 + fr;
#pragma unroll
            for (int ni = 0; ni < 4; ++ni) {
                const size_t o = (size_t)m * D + n0 + wc * 64 + ni * 16 + 4 * fq;
                const f32x4 v = *(const f32x4*)(base + o) + acc[mi][ni];
                *(f32x4*)(out + o) = v;
                if (xb) { u32x2 w; w.x = pk2(v[0], v[1]); w.y = pk2(v[2], v[3]); *(u32x2*)(xb + o) = w; ss += v[0] * v[0] + v[1] * v[1] + v[2] * v[2] + v[3] * v[3]; }
            }
            if (xb) { ss += __shfl_xor(ss, 16); ss += __shfl_xor(ss, 32); if (fq == 0) rsq[(size_t)m * 16 + (n0 >> 6) + wc] = ss; }
        }
    }
};
struct EpiScaleBf16 {
    bf16_t* out; float s; const float* rsq;
    DEV void operator()(f32x4 (&acc)[4][4], int m0, int n0, int wr, int wc, int fr, int fq) const {
#pragma unroll
        for (int mi = 0; mi < 4; ++mi) {
            const int m = m0 + wr * 64 + mi * 16 + fr; const float sr = s * rsqrtf(ld_rsq(rsq + (size_t)m * 16) * (1.0f / D) + EPS);
#pragma unroll
            for (int ni = 0; ni < 4; ++ni) {
                const size_t o = (size_t)m * D + n0 + wc * 64 + ni * 16 + 4 * fq;
                const f32x4 v = acc[mi][ni] * sr; u32x2 w; w.x = pk2(v[0], v[1]); w.y = pk2(v[2], v[3]); *(u32x2*)(out + o) = w;
            }
        }
    }
};
struct EpiRouter {
    const float* brt; unsigned* cnt; int* list; float* ew; const float* rsq; float* srl; float* ewl;
    DEV void operator()(f32x4 (&acc)[4][4], int m0, int n0, int wr, int wc, int fr, int fq) const {
        float* LG = (float*)smem;
        __syncthreads();
        if (wc == 0) {
#pragma unroll
            for (int mi = 0; mi < 4; ++mi) {
                const float sr = rsqrtf(ld_rsq(rsq + (size_t)(m0 + wr * 64 + mi * 16 + fr) * 16) * (1.0f / D) + EPS);
#pragma unroll
                for (int ni = 0; ni < 3; ++ni)
#pragma unroll
                    for (int j = 0; j < 4; ++j) { const int n = ni * 16 + 4 * fq + j; if (n < NRL) LG[(wr * 64 + mi * 16 + fr) * 40 + n] = acc[mi][ni][j] * sr + brt[n]; }
                if (fq == 0) LG[(wr * 64 + mi * 16 + fr) * 40 + NRL] = sr;
            }
        }
        __syncthreads();
        const int tid = threadIdx.x & 255;
        if (tid < 128) {
            const float* lg = LG + tid * 40; const int tok = m0 + tid;
            int gi = 0; float gm = lg[0];
#pragma unroll
            for (int i = 1; i < 4; ++i) if (lg[i] > gm) { gm = lg[i]; gi = i; }
            float gs = 0.f;
#pragma unroll
            for (int i = 0; i < 4; ++i) gs += fexp(lg[i] - gm);
            const float gtop = 1.0f / gs;
            const float* el = lg + 4 + 8 * gi;
            int i1 = 0; float v1 = el[0];
#pragma unroll
            for (int i = 1; i < 8; ++i) if (el[i] > v1) { v1 = el[i]; i1 = i; }
            int i2 = -1; float v2 = -3.0e38f;
#pragma unroll
            for (int i = 0; i < 8; ++i) if (i != i1 && el[i] > v2) { v2 = el[i]; i2 = i; }
            const float e2 = fexp(v2 - v1), inv = 1.0f / (1.0f + e2);
            const float w1 = inv * gtop, w2 = e2 * inv * gtop;
            const int ea = gi * 8 + i1, eb = gi * 8 + i2;
            const float srt = lg[NRL];
            const unsigned pa = atomicAdd(cnt + ea, 1u); list[(size_t)ea * T + pa] = tok * 2; ew[tok * 2] = w1; srl[(size_t)ea * T + pa] = srt; ewl[(size_t)ea * T + pa] = w1;
            const unsigned pb = atomicAdd(cnt + eb, 1u); list[(size_t)eb * T + pb] = tok * 2 + 1; ew[tok * 2 + 1] = w2; srl[(size_t)eb * T + pb] = srt; ewl[(size_t)eb * T + pb] = w2;
        }
    }
};
struct EpiGateUp {
    bf16_t* act; int rowbase; int nvalid; const int* list; const float* rsq;
    DEV void operator()(f32x4 (&acc)[4][4], int m0, int n0, int wr, int wc, int fr, int fq) const {
        int ent[4]; float srv[4];
#pragma unroll
        for (int mi = 0; mi < 4; ++mi) { const int r = m0 + wr * 64 + mi * 16 + fr; ent[mi] = list[r < nvalid ? r : nvalid - 1]; }
#pragma unroll
        for (int mi = 0; mi < 4; ++mi) srv[mi] = rsqrtf(ld_rsq(rsq + (size_t)(ent[mi] >> 1) * 16) * (1.0f / D) + EPS);
#pragma unroll
        for (int mi = 0; mi < 4; ++mi) {
            const int r = m0 + wr * 64 + mi * 16 + fr;
            if (r < nvalid) {
                const float sr = srv[mi];
#pragma unroll
                for (int u = 0; u < 2; ++u) {
                    const f32x4 g = acc[mi][2 * u] * sr, up = acc[mi][2 * u + 1] * sr;
                    const int col = ((n0 + wc * 64) >> 1) + 16 * u + 4 * fq;
                    u32x2 w; w.x = pk2(fsilu(g[0]) * up[0], fsilu(g[1]) * up[1]); w.y = pk2(fsilu(g[2]) * up[2], fsilu(g[3]) * up[3]);
                    *(u32x2*)(act + (size_t)(rowbase + r) * EFF + col) = w;
                }
            }
        }
    }
};
struct EpiDown {
    bf16_t* yb; const int* list; const float* ew; int nvalid;
    DEV void operator()(f32x4 (&acc)[4][4], int m0, int n0, int wr, int wc, int fr, int fq) const {
        int entv[4]; float wv[4];
#pragma unroll
        for (int mi = 0; mi < 4; ++mi) { const int r = m0 + wr * 64 + mi * 16 + fr; entv[mi] = list[r < nvalid ? r : nvalid - 1]; }
#pragma unroll
        for (int mi = 0; mi < 4; ++mi) wv[mi] = ew[entv[mi]];
#pragma unroll
        for (int mi = 0; mi < 4; ++mi) {
            const int r = m0 + wr * 64 + mi * 16 + fr;
            if (r < nvalid) {
                const int ent = entv[mi]; const float w = wv[mi];
#pragma unroll
                for (int ni = 0; ni < 4; ++ni) {
                    const f32x4 v = acc[mi][ni] * w; u32x2 o; o.x = pk2(v[0], v[1]); o.y = pk2(v[2], v[3]);
                    *(u32x2*)(yb + (size_t)ent * D + n0 + wc * 64 + ni * 16 + 4 * fq) = o;
                }
            }
        }
    }
};


namespace pg8 {
#define PG8_LAS __attribute__((address_space(3)))
typedef unsigned short bf16_t;
typedef short bf16x8 __attribute__((ext_vector_type(8)));
typedef float f32x4 __attribute__((ext_vector_type(4)));
typedef unsigned u32x4 __attribute__((ext_vector_type(4)));
constexpr int BM = 256, BK = 64, HALF = 128, HTB = HALF * BK * 2  , STAGE_BYTES = 8 * HTB, NXCD = 8, WGM = 8;

__host__ __device__ __forceinline__ int lds_byte(int r, int c) { const int st = (r >> 4) * 2 + (c >> 5), rr = r & 15, cc = c & 31, ob = rr * 64 + cc * 2; return st * 1024 + (ob ^ (((ob >> 9) & 1) << 5)); }
__host__ __device__ __forceinline__ void stage_rc(int b, int& R, int& C) { const int st = b / 1024, sb = b % 1024, swz = sb ^ (((sb >> 9) & 1) << 5); R = (st >> 1) * 16 + swz / 64; C = (st & 1) * 32 + (swz % 64) / 2; }
__host__ __device__ __forceinline__ int perm32(int rho) { const int n = rho >> 4, i = rho & 15; return 8 * (i >> 2) + 4 * n + (i & 3); }

struct Unit { int pm, pn, e, c, ro, m0; };
struct Gemm { const bf16_t* A; const bf16_t* Bt; int M, N, K; };

struct StaticOrder {
    int nM, nN, nwg, G, c;
    __host__ __device__ void init(int M, int N, int G_, int c_) { nM = M / BM; nN = N / BM; nwg = nM * nN; G = G_; c = c_; }
    static constexpr bool GATHER = false;
    __device__ __forceinline__ const char* a_base(const Gemm& g, const Unit& u, size_t tstep) const { return (const char*)g.A + (size_t)u.pm * tstep; }
    __device__ __forceinline__ const char* b_base(const Gemm& g, const Unit& u, size_t tstep) const { return (const char*)g.Bt + (size_t)u.pn * tstep; }
    __device__ __forceinline__ unsigned gather(const Unit&, int) const { return 0u; }
    static constexpr bool SLABS = false;
    __device__ __forceinline__ int slabs(const Unit&) const { return 4; }
    __host__ __device__ bool next(int i, Unit& u) const {
        u.e = 0; u.c = 0; u.ro = 0; u.m0 = 0;
        const long L = (long)i * G + c; if (L >= nwg) return false;
        int wgid = (int)L; { const int q = nwg / NXCD, r = nwg % NXCD, xcd = wgid % NXCD, off = wgid / NXCD; wgid = (xcd < r ? xcd * (q + 1) : r * (q + 1) + (xcd - r) * q) + off; }
        const int nig = WGM * nN, gid = wgid / nig, fm = gid * WGM, gsz = (nM - fm) < WGM ? (nM - fm) : WGM;
        u.pm = fm + ((wgid % nig) % gsz); u.pn = (wgid % nig) / gsz; return true;
    }
    __device__ __forceinline__ void a_ready(const Unit&) const {}
    __device__ __forceinline__ void done(const Unit&) const {}
};
template <class Epi, class Sched, bool ALIGN_EPI = false, bool SP2 = false>
__device__ __forceinline__ void gemm_phase(PG8_LAS unsigned char* lds, const Gemm g, const Sched& S, const Epi& E) {
    int tid_o = threadIdx.x; asm volatile("" : "+v"(tid_o));
    const int tid = tid_o, wid = __builtin_amdgcn_readfirstlane(tid >> 6), lane = tid & 63, wr = wid >> 2, wc = wid & 3, fr = lane & 15, fq = lane >> 4;
    const int K = g.K, nt = K / BK;
    unsigned voffA[2], voffB[2];
#pragma unroll
    for (int i = 0; i < 2; ++i) { int R, C; stage_rc(tid * 16 + i * 8192, R, C); const int Rb = Epi::PERM ? ((R & ~31) + perm32(R & 31)) : R;
        voffA[i] = (unsigned)(R * K + C) * 2u; voffB[i] = (unsigned)(Rb * K + C) * 2u; }
    const size_t kstep = (size_t)(BK * 2);
    const size_t hstep = (size_t)HALF * K * 2;
    const size_t tstep = 2 * hstep;
    const unsigned ldsw = (unsigned)wid * 1024u;
    const int aoff = lds_byte(wr * 64 + fr, fq * 8), boff = lds_byte(wc * 32 + fr, fq * 8);
#define PG8_SA(b, h) (((b) * 2 + (h)) * HTB)
#define PG8_SB(b, h) ((4 + (b) * 2 + (h)) * HTB)
#define PG8_STAGE(bufoff, gbase, voff) do { _Pragma("unroll") for (int _i = 0; _i < 2; ++_i) \
        __builtin_amdgcn_global_load_lds((const unsigned*)((const char*)(gbase) + (voff)[_i]), (PG8_LAS unsigned*)(lds + (bufoff) + ldsw + _i * 8192), 16, 0, 0); } while (0)
#define PG8_LDA(dst, b, h) do { _Pragma("unroll") for (int m = 0; m < 4; ++m) _Pragma("unroll") for (int k = 0; k < 2; ++k) dst[m][k] = *(const PG8_LAS bf16x8*)(lds + PG8_SA(b, h) + aoff + m * 2048 + k * 1024); } while (0)
#define PG8_LDB(dst, b, h) do { _Pragma("unroll") for (int n = 0; n < 2; ++n) _Pragma("unroll") for (int k = 0; k < 2; ++k) dst[n][k] = *(const PG8_LAS bf16x8*)(lds + PG8_SB(b, h) + boff + n * 2048 + k * 1024); } while (0)
#define PG8_MMA(ai, bj, At, Bt) do { __builtin_amdgcn_s_setprio(1); _Pragma("unroll") for (int m = 0; m < 4; ++m) _Pragma("unroll") for (int n = 0; n < 2; ++n) _Pragma("unroll") for (int k = 0; k < 2; ++k) \
        acc[ai][bj][m][n] = __builtin_amdgcn_mfma_f32_16x16x32_bf16(Bt[n][k], At[m][k], acc[ai][bj][m][n], 0, 0, 0); __builtin_amdgcn_s_setprio(0); } while (0)
#define PG8_WAIT_V(n) asm volatile("s_waitcnt vmcnt(" #n ")" ::: "memory")
#define PG8_WAIT_L(n) asm volatile("s_waitcnt lgkmcnt(" #n ")" ::: "memory")
#define PG8_BAR __builtin_amdgcn_s_barrier()
#define PG8_SCHED __builtin_amdgcn_sched_barrier(0)
    constexpr bool GATHER = Sched::GATHER;
    static_assert(!GATHER || SP2, "gathered A rows: SP2 path only");
    unsigned goffC[2][2] = {{0u, 0u}, {0u, 0u}}, goffN[2][2] = {{0u, 0u}, {0u, 0u}};
    auto goff_ent = [&](const Unit& u, unsigned (&ent)[2][2]) {
#pragma unroll
        for (int h = 0; h < 2; ++h)
#pragma unroll
            for (int i = 0; i < 2; ++i) { int R, C; stage_rc(tid * 16 + i * 8192, R, C); ent[h][i] = S.gather(u, h * HALF + R); }
    };
    auto goff_set = [&](unsigned (&go)[2][2], const unsigned (&ent)[2][2]) {
#pragma unroll
        for (int h = 0; h < 2; ++h)
#pragma unroll
            for (int i = 0; i < 2; ++i) { int R, C; stage_rc(tid * 16 + i * 8192, R, C); go[h][i] = (ent[h][i] * (unsigned)K + (unsigned)C) * 2u; }
    };
#define PG8_STAGE_A(bufoff, base, h, nx) do { if constexpr (GATHER) { _Pragma("unroll") for (int _i = 0; _i < 2; ++_i) { const unsigned _o = (nx) ? goffN[h][_i] : goffC[h][_i]; \
        __builtin_amdgcn_global_load_lds((const unsigned*)((const char*)(base) + _o), (PG8_LAS unsigned*)(lds + (bufoff) + ldsw + _i * 8192), 16, 0, 0); } } \
    else PG8_STAGE(bufoff, (base) + (h) * hstep, voffA); } while (0)
    Unit cur, nxt; int ui = 0;
    if (!S.next(0, cur)) return;
    if constexpr (GATHER) { unsigned ent[2][2]; goff_ent(cur, ent); goff_set(goffC, ent); Unit u1; if (S.next(1, u1)) { goff_ent(u1, ent); goff_set(goffN, ent); } }
    f32x4 acc[2][2][4][2];
#pragma unroll
    for (int a = 0; a < 2; ++a)
#pragma unroll
        for (int b = 0; b < 2; ++b)
#pragma unroll
            for (int m = 0; m < 4; ++m)
#pragma unroll
                for (int n = 0; n < 2; ++n) acc[a][b][m][n] = (f32x4){0.f, 0.f, 0.f, 0.f};
    bf16x8 At[4][2], B0[2][2], B1[2][2];
    constexpr bool SLABS = Sched::SLABS;
    int nvc = S.slabs(cur); bool do0 = !SLABS || wr < nvc, do1 = !SLABS || 2 + wr < nvc;
    const char* cA = S.a_base(g, cur, tstep); const char* cB = S.b_base(g, cur, tstep);
    S.a_ready(cur);
    if constexpr (SP2) {
        PG8_STAGE(PG8_SB(0, 0), cB, voffB); PG8_STAGE(PG8_SB(0, 1), cB + hstep, voffB); PG8_STAGE_A(PG8_SA(0, 0), cA, 0, false); PG8_STAGE_A(PG8_SA(0, 1), cA, 1, false);
        if (wr == 1) PG8_BAR;
        PG8_WAIT_V(2); PG8_BAR;
        PG8_STAGE(PG8_SB(1, 0), cB + kstep, voffB); PG8_STAGE_A(PG8_SA(1, 0), cA + kstep, 0, false); PG8_STAGE(PG8_SB(1, 1), cB + hstep + kstep, voffB);
        PG8_WAIT_V(6); PG8_BAR;
    } else {
        PG8_STAGE(PG8_SB(0, 0), cB, voffB); PG8_STAGE(PG8_SA(0, 0), cA, voffA); PG8_STAGE(PG8_SB(0, 1), cB + hstep, voffB); PG8_STAGE(PG8_SA(0, 1), cA + hstep, voffA);
        if (wr == 1) PG8_BAR;
        PG8_WAIT_V(4); PG8_BAR;
        PG8_STAGE(PG8_SB(1, 0), cB + kstep, voffB); PG8_STAGE(PG8_SA(1, 0), cA + kstep, voffA); PG8_STAGE(PG8_SB(1, 1), cB + hstep + kstep, voffB);
        PG8_WAIT_V(6); PG8_BAR;
    }
    for (;;) {
        const bool has_next = S.next(ui + 1, nxt);
        const char* nA = has_next ? S.a_base(g, nxt, tstep) : cA; const char* nB = has_next ? S.b_base(g, nxt, tstep) : cB;
        for (int t = 0; t < nt; t += 2) {
            const bool last = (t == nt - 2);
            const char* a1 = cA + (size_t)(t + 1) * kstep;
            const char* a2 = last ? nA : cA + (size_t)(t + 2) * kstep; const char* b2 = last ? nB : cB + (size_t)(t + 2) * kstep;
            const char* a3 = a2 + kstep; const char* b3 = b2 + kstep;
            if (last && has_next) S.a_ready(nxt);
            const bool lastn = last && has_next;
            if constexpr (SP2) {
            if (do0) { PG8_LDB(B0, 0, 0); PG8_LDB(B1, 0, 1); } PG8_SCHED; if (do0) PG8_LDA(At, 0, 0); PG8_STAGE_A(PG8_SA(1, 1), a1, 1, false);
            PG8_WAIT_V(8); PG8_WAIT_L(0); PG8_BAR; if (do0) { PG8_MMA(0, 0, At, B0); PG8_MMA(0, 1, At, B1); } PG8_BAR; PG8_SCHED;
            if (do1) PG8_LDA(At, 0, 1); PG8_STAGE(PG8_SB(0, 0), b2, voffB); PG8_STAGE(PG8_SB(0, 1), b2 + hstep, voffB); PG8_STAGE_A(PG8_SA(0, 0), a2, 0, lastn);
            PG8_WAIT_V(8); PG8_WAIT_L(0); PG8_BAR; if (do1) { PG8_MMA(1, 0, At, B0); PG8_MMA(1, 1, At, B1); } PG8_BAR; PG8_SCHED;
            if (do0) { PG8_LDB(B0, 1, 0); PG8_LDB(B1, 1, 1); } PG8_SCHED; if (do0) PG8_LDA(At, 1, 0); PG8_STAGE_A(PG8_SA(0, 1), a2, 1, lastn);
            PG8_WAIT_V(8); PG8_WAIT_L(0); PG8_BAR; if (do0) { PG8_MMA(0, 0, At, B0); PG8_MMA(0, 1, At, B1); } PG8_BAR; PG8_SCHED;
            if (do1) PG8_LDA(At, 1, 1); PG8_STAGE(PG8_SB(1, 0), b3, voffB); PG8_STAGE(PG8_SB(1, 1), b3 + hstep, voffB); PG8_STAGE_A(PG8_SA(1, 0), a3, 0, lastn);
            PG8_WAIT_V(8); PG8_WAIT_L(0); PG8_BAR; if (do1) { PG8_MMA(1, 0, At, B0); PG8_MMA(1, 1, At, B1); } PG8_BAR; PG8_SCHED;
            } else {
            PG8_LDB(B0, 0, 0); PG8_SCHED; PG8_LDA(At, 0, 0); PG8_STAGE(PG8_SA(1, 1), a1 + hstep, voffA);
            PG8_WAIT_L(8); PG8_BAR; PG8_WAIT_L(0); PG8_MMA(0, 0, At, B0); PG8_BAR; PG8_SCHED;
            PG8_LDB(B1, 0, 1); PG8_STAGE(PG8_SB(0, 0), b2, voffB);
            PG8_BAR; PG8_WAIT_L(0); PG8_MMA(0, 1, At, B1); PG8_BAR;
            PG8_LDA(At, 0, 1); PG8_STAGE(PG8_SA(0, 0), a2, voffA);
            PG8_BAR; PG8_WAIT_L(0); PG8_MMA(1, 0, At, B0); PG8_BAR; PG8_SCHED;
            PG8_STAGE(PG8_SB(0, 1), b2 + hstep, voffB);
            PG8_WAIT_V(6); PG8_BAR; PG8_MMA(1, 1, At, B1); PG8_BAR;
            PG8_LDB(B0, 1, 0); PG8_SCHED; PG8_LDA(At, 1, 0); PG8_STAGE(PG8_SA(0, 1), a2 + hstep, voffA);
            PG8_WAIT_L(8); PG8_BAR; PG8_WAIT_L(0); PG8_MMA(0, 0, At, B0); PG8_BAR; PG8_SCHED;
            PG8_LDB(B1, 1, 1); PG8_STAGE(PG8_SB(1, 0), b3, voffB);
            PG8_BAR; PG8_WAIT_L(0); PG8_MMA(0, 1, At, B1); PG8_BAR;
            PG8_LDA(At, 1, 1); PG8_STAGE(PG8_SA(1, 0), a3, voffA);
            PG8_BAR; PG8_WAIT_L(0); PG8_MMA(1, 0, At, B0); PG8_BAR; PG8_SCHED;
            PG8_STAGE(PG8_SB(1, 1), b3 + hstep, voffB);
            PG8_WAIT_V(6); PG8_BAR; PG8_MMA(1, 1, At, B1); PG8_BAR;
            }
        }
        if constexpr (ALIGN_EPI) { if (wr == 0) PG8_BAR; }
        if constexpr (GATHER) {
            Unit u2; const bool has2 = has_next && S.next(ui + 2, u2);
            unsigned ent[2][2] = {{0u, 0u}, {0u, 0u}};
            if (has2) goff_ent(u2, ent);
            E(acc, cur, wr, wc, fr, fq);
#pragma unroll
            for (int h = 0; h < 2; ++h)
#pragma unroll
                for (int i = 0; i < 2; ++i) goffC[h][i] = goffN[h][i];
            if (has2) goff_set(goffN, ent);
        } else
        if constexpr (!Epi::AFTER_DRAIN) { E(acc, cur, wr, wc, fr, fq); S.done(cur); }
        if (!has_next) break;
#pragma unroll
        for (int a = 0; a < 2; ++a)
#pragma unroll
            for (int b = 0; b < 2; ++b)
#pragma unroll
                for (int m = 0; m < 4; ++m)
#pragma unroll
                    for (int n = 0; n < 2; ++n) acc[a][b][m][n] = (f32x4){0.f, 0.f, 0.f, 0.f};
        cur = nxt; cA = nA; cB = nB; ++ui; nvc = S.slabs(cur); do0 = !SLABS || wr < nvc; do1 = !SLABS || 2 + wr < nvc;
        if constexpr (ALIGN_EPI) { if (wr == 1) PG8_BAR; }
    }
    PG8_WAIT_V(0);
    if constexpr (!ALIGN_EPI) { if (wr == 0) PG8_BAR; }
    PG8_BAR;
    if constexpr (Epi::AFTER_DRAIN) { E.fused(acc, cur, wr, wc, fr, fq, lds, wid, lane); S.done(cur); }
#undef PG8_SA
#undef PG8_SB
#undef PG8_STAGE
#undef PG8_STAGE_A
#undef PG8_LDA
#undef PG8_LDB
#undef PG8_MMA
#undef PG8_WAIT_V
#undef PG8_WAIT_L
#undef PG8_BAR
#undef PG8_SCHED
}
}

struct Epi8InProj {
    static constexpr bool PERM = true, AFTER_DRAIN = false;
    EpiInProj e; const float* rstd;
    DEV void operator()(const f32x4 (&acc)[2][2][4][2], const pg8::Unit& u, int wr, int wc, int fr, int fq) const {
        int seg, sb; EpiInProj::segment(u.pn * 256, seg, sb);
        auto& A = const_cast<f32x4 (&)[2][2][4][2]>(acc);
        {
            float rs[2][4];
#pragma unroll
            for (int ai = 0; ai < 2; ++ai)
#pragma unroll
                for (int m = 0; m < 4; ++m) rs[ai][m] = rstd[u.pm * 256 + ai * 128 + wr * 64 + m * 16 + fr];
#pragma unroll
            for (int ai = 0; ai < 2; ++ai)
#pragma unroll
                for (int m = 0; m < 4; ++m)
#pragma unroll
                    for (int bj = 0; bj < 2; ++bj)
#pragma unroll
                        for (int n = 0; n < 2; ++n) A[ai][bj][m][n] *= rs[ai][m];
        }
        if (seg == 6 || seg == 8) {
            const int hd = (seg == 6 ? 0 : 4) + ((u.pn * 256 - sb) >> 8), cc = wc * 32 + 8 * fq;
            f32x4 bo[2], bg[2];
#pragma unroll
            for (int n = 0; n < 2; ++n) { bo[n] = *(const f32x4*)(e.bias + 4608 + hd * 128 + cc + n * 4); bg[n] = *(const f32x4*)(e.bias + 6656 + hd * 128 + cc + n * 4); }
            bf16_t* gp = (bf16_t*)(e.ws + OFF_OG) + hd * 128 + cc;
#pragma unroll
            for (int ai = 0; ai < 2; ++ai)
#pragma unroll
                for (int m = 0; m < 4; ++m) {
                    u32x4 o;
#pragma unroll
                    for (int n = 0; n < 2; ++n) {
                        const f32x4 a = acc[ai][0][m][n] + bo[n], g = acc[ai][1][m][n] + bg[n];
                        const unsigned x = pk2(fsilu(a[0]) * fsigmoid(g[0]), fsilu(a[1]) * fsigmoid(g[1])), y = pk2(fsilu(a[2]) * fsigmoid(g[2]), fsilu(a[3]) * fsigmoid(g[3]));
                        if (n == 0) { o.x = x; o.y = y; } else { o.z = x; o.w = y; }
                    }
                    *(u32x4*)(gp + (size_t)(u.pm * 256 + ai * 128 + wr * 64 + m * 16 + fr) * 1024) = o;
                }
            return;
        }
        const int n00 = u.pn * 256 + wc * 32 + 8 * fq;
        f32x4 bv[2][2], lb[2][2];
#pragma unroll
        for (int bj = 0; bj < 2; ++bj)
#pragma unroll
            for (int n = 0; n < 2; ++n) { bv[bj][n] = *(const f32x4*)(e.bias + n00 + bj * 128 + n * 4); lb[bj][n] = *(const f32x4*)(e.lbt + ((n00 + bj * 128 + n * 4 - sb) & 1023)); }
#pragma unroll
        for (int ai = 0; ai < 2; ++ai)
#pragma unroll
            for (int m = 0; m < 4; ++m)
#pragma unroll
                for (int bj = 0; bj < 2; ++bj)
                    e.put8(seg, sb, u.pm * 256 + ai * 128 + wr * 64 + m * 16 + fr, n00 + bj * 128, acc[ai][bj][m][0], acc[ai][bj][m][1], bv[bj][0], bv[bj][1], lb[bj][0], lb[bj][1]);
    }
};
struct Epi8MemKV {
    static constexpr bool PERM = false, AFTER_DRAIN = false;
    bf16_t* kc; bf16_t* vct;
    DEV void operator()(const f32x4 (&acc)[2][2][4][2], const pg8::Unit& u, int wr, int wc, int fr, int fq) const {
#pragma unroll
        for (int ai = 0; ai < 2; ++ai)
#pragma unroll
            for (int m = 0; m < 4; ++m)
#pragma unroll
                for (int bj = 0; bj < 2; ++bj)
#pragma unroll
                    for (int n = 0; n < 2; ++n) {
                        const int mrow = u.pm * 256 + ai * 128 + wr * 64 + m * 16 + fr, ncol = u.pn * 256 + bj * 128 + wc * 32 + n * 16 + 4 * fq;
                        const int b = mrow >> 8, mm = mrow & 255; const f32x4 v = acc[ai][bj][m][n];
                        if (ncol < 1024) { const int hx = ncol >> 8, d = ncol & 255; u32x2 o; o.x = pk2(v[0], v[1]); o.y = pk2(v[2], v[3]);
                            *(u32x2*)(kc + ((size_t)(b * 4 + hx) * 256 + mm) * 256 + d) = o; }
                        else { const int nn = ncol - 1024, hx = nn >> 8, d = nn & 255; bf16_t* dp = vct + ((size_t)(b * 4 + hx) * 256 + d) * 256 + ((mm & ~31) | (8 * ((mm & 15) >> 2) + 4 * ((mm >> 4) & 1) + (mm & 3)));
#pragma unroll
                            for (int j = 0; j < 4; ++j) dp[j * 256] = f2bf(v[j]); }
                    }
    }
};
struct Epi8Resid {
    static constexpr bool PERM = false, AFTER_DRAIN = false;
    const bf16_t* base; bf16_t* xb; float* rsq;
    DEV void operator()(const f32x4 (&acc)[2][2][4][2], const pg8::Unit& u, int wr, int wc, int fr, int fq) const {
        const size_t o00 = (size_t)(u.pm * 256 + wr * 64 + fr) * D + u.pn * 256 + wc * 32 + 4 * fq;
        u32x2 bv[2][4][2][2];
#pragma unroll
        for (int ai = 0; ai < 2; ++ai)
#pragma unroll
            for (int m = 0; m < 4; ++m)
#pragma unroll
                for (int bj = 0; bj < 2; ++bj)
#pragma unroll
                    for (int n = 0; n < 2; ++n) bv[ai][m][bj][n] = *(const u32x2*)(base + o00 + (size_t)(ai * 128 + m * 16) * D + bj * 128 + n * 16);
#pragma unroll
        for (int ai = 0; ai < 2; ++ai)
#pragma unroll
            for (int m = 0; m < 4; ++m) {
                float ss = 0.f;
#pragma unroll
                for (int bj = 0; bj < 2; ++bj)
#pragma unroll
                    for (int n = 0; n < 2; ++n) {
                        const size_t o = o00 + (size_t)(ai * 128 + m * 16) * D + bj * 128 + n * 16; const u32x2 bb = bv[ai][m][bj][n]; const f32x4 a = acc[ai][bj][m][n];
                        const float x0 = bflo(bb.x) + a[0], x1 = bfhi(bb.x) + a[1], x2 = bflo(bb.y) + a[2], x3 = bfhi(bb.y) + a[3];
                        u32x2 w; w.x = pk2(x0, x1); w.y = pk2(x2, x3); *(u32x2*)(xb + o) = w;
                        ss += x0 * x0 + x1 * x1 + x2 * x2 + x3 * x3;
                    }
                ss += __shfl_xor(ss, 16); ss += __shfl_xor(ss, 32);
                if (fq == 0) rsq[(size_t)(u.pm * 256 + ai * 128 + wr * 64 + m * 16 + fr) * 16 + 4 * u.pn + wc] = ss;
            }
    }
};
struct Epi8ScaleBf16 {
    static constexpr bool PERM = false, AFTER_DRAIN = false;
    bf16_t* out; float s; const float* rsq;
    DEV void operator()(const f32x4 (&acc)[2][2][4][2], const pg8::Unit& u, int wr, int wc, int fr, int fq) const {
        float srv[2][4];
#pragma unroll
        for (int ai = 0; ai < 2; ++ai)
#pragma unroll
            for (int m = 0; m < 4; ++m) srv[ai][m] = s * rsqrtf(ld_rsq(rsq + (size_t)(u.pm * 256 + ai * 128 + wr * 64 + m * 16 + fr) * 16) * (1.0f / D) + EPS);
#pragma unroll
        for (int ai = 0; ai < 2; ++ai)
#pragma unroll
            for (int m = 0; m < 4; ++m) {
                const int mrow = u.pm * 256 + ai * 128 + wr * 64 + m * 16 + fr; const float sr = srv[ai][m];
#pragma unroll
                for (int bj = 0; bj < 2; ++bj)
#pragma unroll
                    for (int n = 0; n < 2; ++n) {
                        const size_t o = (size_t)mrow * D + u.pn * 256 + bj * 128 + wc * 32 + n * 16 + 4 * fq;
                        const f32x4 v = acc[ai][bj][m][n] * sr; u32x2 w; w.x = pk2(v[0], v[1]); w.y = pk2(v[2], v[3]); *(u32x2*)(out + o) = w;
                    }
            }
    }
};
template <class Epi> DEV void dense_gemm(const bf16_t* A, const bf16_t* Bt, int M, int N, int K, const Epi& E, int c0 = 0, int gsub = 0) {
    pg8::Gemm g{A, Bt, M, N, K};
    if (gsub > 0 && ((int)blockIdx.x < c0 || (int)blockIdx.x >= c0 + gsub)) return;
    pg8::StaticOrder S; S.init(M, N, gsub > 0 ? gsub : (int)gridDim.x, (int)blockIdx.x - c0);
    pg8::gemm_phase<Epi, pg8::StaticOrder, true, true>((PG8_LAS unsigned char*)smem_all, g, S, E);
}

DEV void swa_naive_unit(const Params& p, int l, int unit) {
    unsigned char* ws = p.ws;
    const int tid = otid(), h = unit & 15, nb = (unit >> 4) & 15, b = unit >> 8, kvh = h >> 2;
    bf16_t* Ks = (bf16_t*)smem;
    bf16_t* Vt = (bf16_t*)(smem + 32768);
    const bf16_t* KA = (const bf16_t*)(ws + OFF_KA); const bf16_t* VAT = (const bf16_t*)(ws + OFF_VAT);
    __syncthreads();
    for (int i = tid; i < 2048; i += 256) {
        { const int kj = i >> 3, ch = i & 7, s = 128 * (nb - 1) + kj; u32x4 v = (u32x4){0u, 0u, 0u, 0u};
          if (s >= 0) v = *(const u32x4*)(KA + (size_t)(b * SEQ + s) * 256 + kvh * 64 + ch * 8);
          *(u32x4*)(Ks + kj * 64 + ch * 8) = v; }
        { const int d = i >> 5, ch = i & 31, s0 = 128 * (nb - 1) + ch * 8; u32x4 v = (u32x4){0u, 0u, 0u, 0u};
          if (s0 >= 0) v = *(const u32x4*)(VAT + ((size_t)(b * 4 + kvh) * 64 + d) * SEQ + s0);
          const unsigned vw[4] = {v.x, v.y, v.z, v.w};
#pragma unroll
          for (int e = 0; e < 8; ++e) { const int pos = ch * 8 + e, key = (pos & ~15) | perm16(pos & 15); Vt[d * 256 + key] = (bf16_t)((e & 1) ? (vw[e >> 1] >> 16) : (vw[e >> 1] & 0xffffu)); } }
    }
    __syncthreads();
    const int q = tid & 127, dh = tid >> 7, tok = b * SEQ + nb * 128 + q;
    float qv[64];
    { const bf16_t* qp = (const bf16_t*)(ws + OFF_QA) + (size_t)tok * 1024 + h * 64;
#pragma unroll
      for (int c = 0; c < 8; ++c) { const u32x4 w = *(const u32x4*)(qp + c * 8);
          qv[c * 8 + 0] = bflo(w.x); qv[c * 8 + 1] = bfhi(w.x); qv[c * 8 + 2] = bflo(w.y); qv[c * 8 + 3] = bfhi(w.y);
          qv[c * 8 + 4] = bflo(w.z); qv[c * 8 + 5] = bfhi(w.z); qv[c * 8 + 6] = bflo(w.w); qv[c * 8 + 7] = bfhi(w.w); } }
    float mrun = p.attn_sinks[l * 16 + h], lrun = 1.0f, o[32];
#pragma unroll
    for (int d = 0; d < 32; ++d) o[d] = 0.f;
    int k_lo = q + 1; if (nb == 0 && k_lo < 128) k_lo = 128;
    for (int kj = k_lo; kj <= q + 128; ++kj) {
        float s = 0.f;
#pragma unroll
        for (int c = 0; c < 8; ++c) { const u32x4 w = *(const u32x4*)(Ks + kj * 64 + c * 8);
            s += qv[c * 8 + 0] * bflo(w.x) + qv[c * 8 + 1] * bfhi(w.x) + qv[c * 8 + 2] * bflo(w.y) + qv[c * 8 + 3] * bfhi(w.y)
               + qv[c * 8 + 4] * bflo(w.z) + qv[c * 8 + 5] * bfhi(w.z) + qv[c * 8 + 6] * bflo(w.w) + qv[c * 8 + 7] * bfhi(w.w); }
        const float mn = fmaxf(mrun, s), a = fexp(mrun - mn), pe = fexp(s - mn);
        lrun = lrun * a + pe; mrun = mn;
#pragma unroll
        for (int d = 0; d < 32; ++d) o[d] = o[d] * a + pe * bf2f(Vt[(dh * 32 + d) * 256 + kj]);
    }
    const float inv = 1.0f / lrun;
    const bf16_t* ga = (const bf16_t*)(ws + OFF_GA) + (size_t)tok * 1024 + h * 64 + dh * 32;
    bf16_t* mo = (bf16_t*)(ws + OFF_MIXA) + (size_t)tok * 1024 + h * 64 + dh * 32;
#pragma unroll
    for (int d = 0; d < 32; ++d) mo[d] = f2bf(o[d] * inv * bf2f(ga[d]));
}

DEV void hgrn_naive_unit(const Params& p, int l, int unit) {
    unsigned char* ws = p.ws;
    const int tid = otid(), lane = tid & 63, wid = tid >> 6, h = unit & 7, b = unit >> 3;
    const int dv = tid & 127, kh2 = tid >> 7;
    float* Lq = (float*)smem;
    float* Lk = Lq + 2048; float* Lf = Lk + 2048;
    float* Lo = Lf + 2048;
    const bf16_t* QH = (const bf16_t*)(ws + OFF_QH); const bf16_t* KH = (const bf16_t*)(ws + OFF_KH); const float* LOGF = (const float*)(ws + OFF_LOGF);
    const bf16_t* vrow = (const bf16_t*)(ws + OFF_VHT) + ((size_t)(b * 8 + h) * 128 + dv) * SEQ;
    float st[64];
#pragma unroll
    for (int k = 0; k < 64; ++k) st[k] = 0.f;
    for (int t0 = 0; t0 < SEQ; t0 += 16) {
        __syncthreads();
        for (int i = tid; i < 2048; i += 256) { const int tt = i >> 7, k = i & 127; const size_t g = (size_t)(b * SEQ + t0 + tt) * 1024 + h * 128 + k;
            Lq[i] = bf2f(QH[g]); Lk[i] = bf2f(KH[g]); Lf[i] = fexp(LOGF[g]); }
        const u32x4 va = *(const u32x4*)(vrow + t0), vb = *(const u32x4*)(vrow + t0 + 8);
        float vv[16] = {bflo(va.x), bfhi(va.x), bflo(va.y), bfhi(va.y), bflo(va.z), bfhi(va.z), bflo(va.w), bfhi(va.w),
                        bflo(vb.x), bfhi(vb.x), bflo(vb.y), bfhi(vb.y), bflo(vb.z), bfhi(vb.z), bflo(vb.w), bfhi(vb.w)};
        __syncthreads();
#pragma unroll
        for (int tt = 0; tt < 16; ++tt) {
            const float v = vv[tt]; float o = 0.f;
            const float* fq_ = Lq + tt * 128 + kh2 * 64; const float* fk_ = Lk + tt * 128 + kh2 * 64; const float* ff_ = Lf + tt * 128 + kh2 * 64;
#pragma unroll
            for (int k = 0; k < 64; ++k) { st[k] = ff_[k] * st[k] + fk_[k] * v; o += fq_[k] * st[k]; }
            Lo[(kh2 * 16 + tt) * 128 + dv] = o;
        }
        __syncthreads();
#pragma unroll
        for (int i = 0; i < 4; ++i) {
            const int tt = wid * 4 + i; const size_t g = (size_t)(b * SEQ + t0 + tt) * 1024 + h * 128;
            const float o0 = Lo[tt * 128 + lane] + Lo[(16 + tt) * 128 + lane], o1 = Lo[tt * 128 + 64 + lane] + Lo[(16 + tt) * 128 + 64 + lane];
            const float ss = wave_sum(o0 * o0 + o1 * o1), rstd = rsqrtf(ss * (1.0f / 128.0f) + EPS);
            const float w0 = p.hg_out_norm[l * 128 + lane], w1 = p.hg_out_norm[l * 128 + 64 + lane];
            const bf16_t* og = (const bf16_t*)(ws + OFF_OG) + g; const bf16_t* gh = (const bf16_t*)(ws + OFF_GH) + g; bf16_t* mh = (bf16_t*)(ws + OFF_MIXH) + g;
            mh[lane] = f2bf(o0 * rstd * w0 * bf2f(og[lane]) * bf2f(gh[lane]));
            mh[64 + lane] = f2bf(o1 * rstd * w1 * bf2f(og[64 + lane]) * bf2f(gh[64 + lane]));
        }
    }
}

DEV void xattn_naive_unit(const Params& p, int l, int unit) {
    unsigned char* ws = p.ws;
    const int tid = otid(), lane = tid & 63, wid = tid >> 6, tt0 = (unit & 63) * 32, hx = (unit >> 6) & 3, b = unit >> 8;
    float* Qs = (float*)smem;
    float* Ss = Qs + 8192;
    const bf16_t* QC = (const bf16_t*)(ws + OFF_QC);
    const bf16_t* kc = (const bf16_t*)(ws + OFF_KC) + (size_t)l * TMEM * D + (size_t)(b * 4 + hx) * 65536;
    const bf16_t* vct = (const bf16_t*)(ws + OFF_VCT) + (size_t)l * TMEM * D + (size_t)(b * 4 + hx) * 65536;
    __syncthreads();
    for (int i = tid; i < 8192; i += 256) { const int tk = i >> 8, d = i & 255; Qs[i] = bf2f(QC[(size_t)(b * SEQ + tt0 + tk) * 1024 + hx * 256 + d]); }
    __syncthreads();
    float acc[32];
#pragma unroll
    for (int i = 0; i < 32; ++i) acc[i] = 0.f;
    for (int dc = 0; dc < 32; ++dc) {
        const u32x4 w = *(const u32x4*)(kc + (size_t)tid * 256 + dc * 8);
        const float kv[8] = {bflo(w.x), bfhi(w.x), bflo(w.y), bfhi(w.y), bflo(w.z), bfhi(w.z), bflo(w.w), bfhi(w.w)};
#pragma unroll
        for (int tk = 0; tk < 32; ++tk) { const float* qp = Qs + tk * 256 + dc * 8;
#pragma unroll
            for (int j = 0; j < 8; ++j) acc[tk] += qp[j] * kv[j]; }
    }
#pragma unroll
    for (int tk = 0; tk < 32; ++tk) Ss[tk * 256 + tid] = acc[tk];
    __syncthreads();
#pragma unroll 1
    for (int i = 0; i < 8; ++i) {
        float* sp = Ss + (wid * 8 + i) * 256;
        const float s0 = sp[lane], s1 = sp[lane + 64], s2 = sp[lane + 128], s3 = sp[lane + 192];
        const float m = wave_max(fmaxf(fmaxf(s0, s1), fmaxf(s2, s3)));
        const float e0 = fexp(s0 - m), e1 = fexp(s1 - m), e2 = fexp(s2 - m), e3 = fexp(s3 - m);
        const float inv = 1.0f / wave_sum(e0 + e1 + e2 + e3);
        sp[lane] = e0 * inv; sp[lane + 64] = e1 * inv; sp[lane + 128] = e2 * inv; sp[lane + 192] = e3 * inv;
    }
    __syncthreads();
#pragma unroll
    for (int i = 0; i < 32; ++i) acc[i] = 0.f;
    for (int jc = 0; jc < 32; ++jc) {
        const u32x4 w = *(const u32x4*)(vct + (size_t)tid * 256 + jc * 8);
        const float vv[8] = {bflo(w.x), bfhi(w.x), bflo(w.y), bfhi(w.y), bflo(w.z), bfhi(w.z), bflo(w.w), bfhi(w.w)};
#pragma unroll
        for (int tk = 0; tk < 32; ++tk) { const float* pp = Ss + tk * 256 + (jc >> 2) * 32;
#pragma unroll
            for (int j = 0; j < 8; ++j) { const int pos = (jc & 3) * 8 + j; acc[tk] += pp[16 * ((pos >> 2) & 1) + 4 * (pos >> 3) + (pos & 3)] * vv[j]; } }
    }
    bf16_t* oc = (bf16_t*)(ws + OFF_OC);
#pragma unroll
    for (int tk = 0; tk < 32; ++tk) oc[(size_t)(b * SEQ + tt0 + tk) * 1024 + hx * 256 + tid] = f2bf(acc[tk]);
}


#define MFMA32(a, b, c) __builtin_amdgcn_mfma_f32_32x32x16_bf16((a), (b), (c), 0, 0, 0)
#define MFMA16(a, b, c) __builtin_amdgcn_mfma_f32_16x16x32_bf16((a), (b), (c), 0, 0, 0)
DEV f32x16 zero16() { f32x16 z; for (int i = 0; i < 16; ++i) z[i] = 0.f; return z; }

constexpr int HF_BUF = 19456;
constexpr int HF_TOT = 2 * HF_BUF, HF_Q3 = HF_TOT + 2048, HF_K3D = HF_Q3 + 8192, HF_K3O = HF_K3D + 8192, HF_RS = HF_K3O + 4096, HF_HW = HF_RS + 1024, HF_OUT = HF_HW + 512, HF_GP = HF_OUT + 16384;
DEV void hf_bar() { asm volatile("s_waitcnt lgkmcnt(0)" ::: "memory"); __builtin_amdgcn_s_barrier(); asm volatile("" ::: "memory"); }
DEV void hgrn_fused_block(const Params& p, int l, int unit) {
    unsigned char* ws = p.ws;
    unsigned char* L = smem_all;
    const int tid = otid(), lane = tid & 63, w = __builtin_amdgcn_readfirstlane(tid >> 6);
    const int h = unit & 7, b = unit >> 3;
    __syncthreads();
    if (vhalf() != 0) {
        const int k0 = 2 * lane, tq = w, sub = tq >> 1, qh = tq & 1;
        const size_t gb = (size_t)(b * SEQ + 8 * tq) * 1024 + h * 128 + k0;
        const _Float16* LOGF = (const _Float16*)(ws + OFF_LOGF) + gb; const bf16_t* QH = (const bf16_t*)(ws + OFF_QH) + gb;
        const int kq = (k0 & ~15) | perm16(k0 & 15);
        const int c1 = kq >> 3, o1 = (kq & 7) * 2;
        const int c3 = k0 >> 3, o3 = (k0 & 7) * 2;
        const int k2o = 8192 + k0 * 64 + ((tq ^ ((k0 >> 2) & 3)) << 4);
        const bf16_t* GPp = (const bf16_t*)(ws + OFF_OG) + gb;
        const int gpo = ((lane >> 2) << 4) + (lane & 3) * 4;
        typedef _Float16 h16x2 __attribute__((ext_vector_type(2)));
        h16x2 LF0[8], LF1[8]; float2 bl[8]; unsigned Qa[8], Qb[8], Ga[8], Gb[8];
        auto ld_lf = [&](int n, h16x2 (&lf)[8]) {
            const _Float16* s = LOGF + (size_t)(n < 63 ? n : 63) * 32768;
#pragma unroll
            for (int j = 0; j < 8; ++j) lf[j] = *(const h16x2*)(s + j * 1024);
        };
        auto ld_qk = [&](int n, unsigned (&q)[8], unsigned (&gp)[8]) {
            const size_t o = (size_t)(n < 63 ? n : 63) * 32768;
#pragma unroll
            for (int j = 0; j < 8; ++j) { q[j] = *(const unsigned*)(QH + o + j * 1024); gp[j] = *(const unsigned*)(GPp + o + j * 1024); }
        };
        auto gates = [&](int n, const unsigned (&gp)[8]) {
            unsigned char* GPt = L + HF_GP + (n & 1) * 8192;
#pragma unroll
            for (int j = 0; j < 8; ++j) { const int t = 8 * tq + j, tx = 8 * qh + j; *(unsigned*)(GPt + t * 256 + (gpo ^ (tx << 4))) = gp[j]; }
        };
        auto expo = [&](int n, const unsigned (&q)[8]) {
            const float* TOT = (const float*)(L + HF_TOT) + k0;
            const float2 t0 = *(const float2*)(TOT), t1 = *(const float2*)(TOT + 128), t2 = *(const float2*)(TOT + 256), t3 = *(const float2*)(TOT + 384);
            const float s0x = t0.x + t1.x, s0y = t0.y + t1.y, s1x = t2.x + t3.x, s1y = t2.y + t3.y, blx = s0x + s1x, bly = s0y + s1y;
            const float qox = qh ? (sub ? t2.x : t0.x) : 0.f, qoy = qh ? (sub ? t2.y : t0.y) : 0.f;
            unsigned char* B = L + (n & 1) * HF_BUF;
            unsigned k2a[4], k2b[4]; float px = 0.f, py = 0.f;
            typedef float f2 __attribute__((ext_vector_type(2)));
            auto ex2 = [](f2 x) { const f2 t = x * 1.44269504089f; return (f2){__builtin_amdgcn_exp2f(t.x), __builtin_amdgcn_exp2f(t.y)}; };
            const f2 ec = ex2(sub ? (f2){s0x, s0y} : (f2){s1x, s1y});
            const f2 one = (f2){1.f, 1.f}, m1 = sub ? ec : one, m2 = sub ? one : ec, c3v = sub ? (f2){s1x, s1y} : (f2){s0x, s0y}, qo = (f2){qox, qoy};
#pragma unroll
            for (int j = 0; j < 8; ++j) {
                const int t = 8 * tq + j, tx = 8 * qh + j;
                const f2 blj = (f2){bl[j].x, bl[j].y}, bv = blj + qo;
                const f2 lf = j ? blj - (f2){bl[j > 0 ? j - 1 : 0].x, bl[j > 0 ? j - 1 : 0].y} : blj;
                const f2 qv = (f2){bflo(q[j]), bfhi(q[j])}, kv = one - ex2(lf);
                const f2 q3 = qv * ex2(bv), ko = kv * ex2(c3v - bv);
                const f2 nb = (f2){fminf(-bv.x, 80.f), fminf(-bv.y, 80.f)}, kd = kv * ex2(nb), k2 = ko * m2, q1 = q3 * m1;
                const int ro1 = t * 256 + ((c1 ^ tx) << 4) + o1, ro3 = t * 256 + ((c3 ^ tx) << 4) + o3;
                *(unsigned*)(B + ro1) = pk2(q1.x, q1.y);
                *(unsigned*)(L + HF_Q3 + ro3) = pk2(q3.x, q3.y);
                *(unsigned*)(L + HF_K3D + ro3) = pk2(kd.x, kd.y);
                if (!sub) *(unsigned*)(L + HF_K3O + ro3) = pk2(ko.x, ko.y);
                if (j & 1) { k2a[j >> 1] = pk2(px, k2.x); k2b[j >> 1] = pk2(py, k2.y); } else { px = k2.x; py = k2.y; }
            }
            *(u32x4*)(B + k2o) = (u32x4){k2a[0], k2a[1], k2a[2], k2a[3]};
            *(u32x4*)(B + k2o + 64) = (u32x4){k2b[0], k2b[1], k2b[2], k2b[3]};
            if (tq == 3) *(float2*)(B + 18432 + k0 * 4) = make_float2(fexp(blx), fexp(bly));
        };
        auto amat = [&](int n) {
            unsigned char* AMl = L + (n & 1) * HF_BUF + 16384;
            const int fr = lane & 15, fq = lane >> 4;
            if (tq == 3) { *(u32x2*)(AMl + fr * 64 + (((2 + (fq >> 1)) ^ ((fr >> 2) & 3)) << 4) + 8 * (fq & 1)) = (u32x2){0u, 0u}; }
            else {
                const int ta = tq == 0 ? 0 : 16, sa = tq == 1 ? 16 : 0;
                const unsigned char* Bs = L + (tq == 2 ? HF_K3O : HF_K3D);
                f32x4 acc = (f32x4){0.f, 0.f, 0.f, 0.f};
#pragma unroll
                for (int k4 = 0; k4 < 4; ++k4) {
                    const bf16x8 qf = *(const bf16x8*)(L + HF_Q3 + (ta + fr) * 256 + (((k4 * 4 + fq) ^ fr) << 4));
                    const bf16x8 kf = *(const bf16x8*)(Bs + (sa + fr) * 256 + (((k4 * 4 + fq) ^ fr) << 4));
                    acc = MFMA16(kf, qf, acc);
                }
                if (tq != 2) {
#pragma unroll
                    for (int j = 0; j < 4; ++j) if (4 * fq + j > fr) acc[j] = 0.f;
                }
                u32x2 o; o.x = pk2(acc[0], acc[1]); o.y = pk2(acc[2], acc[3]);
                const int t = ta + fr;
                *(u32x2*)(AMl + t * 64 + ((((sa >> 3) + (fq >> 1)) ^ ((t >> 2) & 3)) << 4) + 8 * (fq & 1)) = o;
            }
        };
        auto csum = [&](const h16x2 (&lf)[8]) {
            float rx = 0.f, ry = 0.f;
#pragma unroll
            for (int j = 0; j < 8; ++j) { rx += (float)lf[j][0]; ry += (float)lf[j][1]; bl[j] = make_float2(rx, ry); }
            *(float2*)(L + HF_TOT + tq * 512 + k0 * 4) = make_float2(rx, ry);
        };
        auto pstep = [&](int c, unsigned (&q)[8], unsigned (&gp)[8], h16x2 (&lf)[8]) {
            if (c + 1 >= 0 && c + 1 < 64) { expo(c + 1, q); gates(c + 1, gp); }
            ld_qk(c + 3, q, gp);
            hf_bar();
            if (c + 1 >= 0 && c + 1 < 64) amat(c + 1);
            csum(lf); ld_lf(c + 4, lf);
            hf_bar();
        };
        ld_lf(0, LF0); ld_lf(1, LF1); ld_qk(0, Qa, Ga);
#pragma unroll 1
        for (int c = -2; c < 64; c += 2) { pstep(c, Qb, Gb, LF0); pstep(c + 1, Qa, Ga, LF1); }
    } else {
        const int l31 = lane & 31, hh = lane >> 5;
        const bf16_t* vrow = (const bf16_t*)(ws + OFF_VHT) + ((size_t)unit * 128 + 32 * w + l31) * SEQ + 8 * hh;
        const size_t tok0 = (size_t)(b * SEQ + l31) * 1024 + h * 128 + 32 * w + 4 * hh;
        const int q1f = l31 * 256, q1x = l31 & 15;
        const int k2f = 8192 + l31 * 64, k2x = (l31 >> 2) & 3;
        const int amf = 16384 + l31 * 64;
        const int ddf = 18432 + 16 * hh;
        float* HW = (float*)(L + HF_HW);
        float* RS = (float*)(L + HF_RS);
        const float* hwp = HW + 32 * w + 4 * hh;
        if (tid < 128) HW[tid] = p.hg_out_norm[l * 128 + tid];
        f32x16 S[4], oT = zero16();
#pragma unroll
        for (int i = 0; i < 4; ++i) S[i] = zero16();
        bf16x8 V0[2], V1[2];
        auto ld_v = [&](int n, bf16x8 (&v)[2]) { const int cn = n < 63 ? n : 63; v[0] = *(const bf16x8*)(vrow + cn * 32); v[1] = *(const bf16x8*)(vrow + cn * 32 + 16); };
        auto consA = [&](int c, const bf16x8 (&vf)[2]) {
            const unsigned char* B = L + (c & 1) * HF_BUF;
            bf16x8 qfr[8], afr[2];
#pragma unroll
            for (int i = 0; i < 8; ++i) qfr[i] = *(const bf16x8*)(B + q1f + (((2 * i + hh) ^ q1x) << 4));
#pragma unroll
            for (int s2 = 0; s2 < 2; ++s2) afr[s2] = *(const bf16x8*)(B + amf + (((2 * s2 + hh) ^ k2x) << 4));
            __builtin_amdgcn_sched_barrier(0);
            oT = zero16();
#pragma unroll
            for (int i = 0; i < 8; ++i) oT = MFMA32(pack8(S[i >> 1], i & 1), qfr[i], oT);
#pragma unroll
            for (int s2 = 0; s2 < 2; ++s2) oT = MFMA32(vf[s2], afr[s2], oT);
#pragma unroll
            for (int kb = 0; kb < 4; ++kb) {
                f32x4 dd[4]; bf16x8 kfr[2];
#pragma unroll
                for (int g = 0; g < 4; ++g) dd[g] = *(const f32x4*)(B + ddf + kb * 128 + g * 32);
                kfr[0] = *(const bf16x8*)(B + k2f + kb * 2048 + (((0 + hh) ^ k2x) << 4)); kfr[1] = *(const bf16x8*)(B + k2f + kb * 2048 + (((2 + hh) ^ k2x) << 4));
#pragma unroll
                for (int g = 0; g < 4; ++g) { S[kb][4 * g + 0] *= dd[g][0]; S[kb][4 * g + 1] *= dd[g][1]; S[kb][4 * g + 2] *= dd[g][2]; S[kb][4 * g + 3] *= dd[g][3]; }
                S[kb] = MFMA32(kfr[0], vf[0], S[kb]); S[kb] = MFMA32(kfr[1], vf[1], S[kb]);
            }
            float ss = 0.f;
#pragma unroll
            for (int i = 0; i < 16; ++i) ss += oT[i] * oT[i];
            ss += __shfl_xor(ss, 32);
            if (hh == 0) RS[(c & 1) * 128 + w * 32 + l31] = ss;
        };
        auto consB = [&](int c) {
            const float tot = RS[(c & 1) * 128 + l31] + RS[(c & 1) * 128 + 32 + l31] + RS[(c & 1) * 128 + 64 + l31] + RS[(c & 1) * 128 + 96 + l31];
            const float rstd = rsqrtf(tot * (1.0f / 128.0f) + EPS);
            unsigned char* O = L + HF_OUT + (c & 1) * 8192 + l31 * 256 + 8 * hh;
            const unsigned char* GPt = L + HF_GP + (c & 1) * 8192 + l31 * 256 + 8 * hh;
#pragma unroll
            for (int g = 0; g < 4; ++g) {
                const f32x4 hw = *(const f32x4*)(hwp + 8 * g);
                const u32x2 gp = *(const u32x2*)(GPt + (((4 * w + g) ^ (l31 & 15)) << 4));
                const float v0 = oT[4 * g + 0] * rstd * hw[0] * bflo(gp.x), v1 = oT[4 * g + 1] * rstd * hw[1] * bfhi(gp.x);
                const float v2 = oT[4 * g + 2] * rstd * hw[2] * bflo(gp.y), v3 = oT[4 * g + 3] * rstd * hw[3] * bfhi(gp.y);
                u32x2 o; o.x = pk2(v0, v1); o.y = pk2(v2, v3); *(u32x2*)(O + (((4 * w + g) ^ (l31 & 15)) << 4)) = o;
            }
        };
        auto out_store = [&](int c) {
            const unsigned char* O = L + HF_OUT + (c & 1) * 8192;
            bf16_t* mrow = (bf16_t*)(ws + OFF_MIXA) + (size_t)(b * SEQ + (c < 0 ? 0 : c) * 32) * 2048 + 1024 + h * 128;
#pragma unroll
            for (int i = 0; i < 2; ++i) {
                const int idx = tid + 256 * i, t = idx >> 4, j = idx & 15;
                const u32x4 v = *(const u32x4*)(O + t * 256 + ((j ^ (t & 15)) << 4));
                *(u32x4*)(mrow + (size_t)t * 2048 + j * 8) = v;
            }
        };
        auto cstep = [&](int c, bf16x8 (&vf)[2]) {
            consA(c, vf); ld_v(c + 2, vf); out_store(c - 1);
            hf_bar();
            consB(c);
            hf_bar();
        };
        ld_v(0, V0); ld_v(1, V1);
        hf_bar(); hf_bar(); hf_bar(); hf_bar();
#pragma unroll 1
        for (int c = 0; c < 64; c += 2) { cstep(c, V0); cstep(c + 1, V1); }
        out_store(63);
    }
}

DEV void swa_fast_unit(const Params& p, int l, int unit) {
    unsigned char* ws = p.ws;
    const int tid = otid(), lane = tid & 63, w = tid >> 6, l31 = lane & 31, hh = lane >> 5;
    const int wu = __builtin_amdgcn_readfirstlane(w);
    const int h = unit & 15, nb = (unit >> 4) & 15, b = unit >> 8, kvh = h >> 2;
    const size_t tok = (size_t)b * SEQ + nb * 128 + 32 * w + l31;
    const bf16_t* qp = (const bf16_t*)(ws + OFF_QA) + tok * 1024 + h * 64 + 8 * hh;
    bf16x8 qf[4];
#pragma unroll
    for (int s2 = 0; s2 < 4; ++s2) qf[s2] = *(const bf16x8*)(qp + 16 * s2);
    const int s0 = 128 * (nb - 1);
    {
        const bf16_t* KA = (const bf16_t*)(ws + OFF_KA) + (size_t)b * SEQ * 256 + kvh * 64;
        const bf16_t* VT = (const bf16_t*)(ws + OFF_VAT) + (size_t)(b * 4 + kvh) * 64 * SEQ;
        __syncthreads();
#pragma unroll
        for (int j = 0; j < 8; ++j) {
            const int pc = wu * 8 + j;
            { const int row = pc * 8 + (lane >> 3), pos = lane & 7, sc = pos ^ ((row >> 1) & 7); int s = s0 + row; if (s < 0) s += 128;
              __builtin_amdgcn_global_load_lds((const unsigned*)(KA + (size_t)s * 256 + sc * 8), (unsigned*)(smem + pc * 1024 + lane * 16), 16, 0, 0); }
            { const int row = pc * 2 + (lane >> 5), pos = lane & 31, sc = pos ^ (row & 15); int s = s0 + sc * 8; if (s < 0) s += 128;
              __builtin_amdgcn_global_load_lds((const unsigned*)(VT + (size_t)row * SEQ + s), (unsigned*)(smem + 32768 + pc * 1024 + lane * 16), 16, 0, 0); }
        }
        asm volatile("s_waitcnt vmcnt(0)" ::: "memory");
        __syncthreads();
    }
    const int ks0 = s0 + 32 * w;
    f32x16 sc[5];
#pragma unroll
    for (int i = 0; i < 5; ++i) {
        sc[i] = zero16();
        const int row = 32 * (w + i) + l31; const unsigned char* kb = smem + row * 128; const int kx = (row >> 1) & 7;
#pragma unroll
        for (int s2 = 0; s2 < 4; ++s2) { const bf16x8 kf = *(const bf16x8*)(kb + (((2 * s2 + hh) ^ kx) << 4)); sc[i] = MFMA32(kf, qf[s2], sc[i]); }
    }
    const float sink = p.attn_sinks[l * 16 + h];
    float m = sink;
#pragma unroll
    for (int i = 0; i < 5; ++i) {
        const bool bv = (ks0 + 32 * i) >= 0;
#pragma unroll
        for (int r = 0; r < 16; ++r) {
            const int kr = (r & 3) + 8 * (r >> 2) + 4 * hh;
            const bool ok = bv && (i == 0 ? kr > l31 : (i == 4 ? kr <= l31 : true));
            sc[i][r] = ok ? sc[i][r] : -1.0e30f;
            m = fmaxf(m, sc[i][r]);
        }
    }
    m = fmaxf(m, __shfl_xor(m, 32));
    float lsum = 0.f;
#pragma unroll
    for (int i = 0; i < 5; ++i)
#pragma unroll
        for (int r = 0; r < 16; ++r) { const float e = sc[i][r] > -1.0e29f ? fexp(sc[i][r] - m) : 0.f; sc[i][r] = e; lsum += e; }
    lsum += __shfl_xor(lsum, 32);
    const float inv = 1.0f / (lsum + fexp(sink - m));
    f32x16 o0 = zero16(), o1 = zero16();
    {
        const unsigned char* v0b = smem + 32768 + l31 * 512; const unsigned char* v1b = v0b + 32 * 512; const int vx = l31 & 15;
#pragma unroll
        for (int i = 0; i < 5; ++i)
#pragma unroll
            for (int s2 = 0; s2 < 2; ++s2) {
                const int c = 4 * (w + i) + 2 * s2 + hh;
                const bf16x8 pb = pack8(sc[i], s2);
                const bf16x8 va = *(const bf16x8*)(v0b + ((c ^ vx) << 4)), vb = *(const bf16x8*)(v1b + ((c ^ vx) << 4));
                o0 = MFMA32(va, pb, o0); o1 = MFMA32(vb, pb, o1);
            }
    }
    const bf16_t* ga = (const bf16_t*)(ws + OFF_GA) + tok * 1024 + h * 64 + 4 * hh;
    bf16_t* mo = (bf16_t*)(ws + OFF_MIXA) + tok * 2048 + h * 64 + 4 * hh;
#pragma unroll
    for (int g = 0; g < 4; ++g) {
        const u32x2 ga0 = *(const u32x2*)(ga + 8 * g), ga1 = *(const u32x2*)(ga + 32 + 8 * g);
        u32x2 a, c2;
        a.x = pk2(o0[4 * g + 0] * inv * bflo(ga0.x), o0[4 * g + 1] * inv * bfhi(ga0.x)); a.y = pk2(o0[4 * g + 2] * inv * bflo(ga0.y), o0[4 * g + 3] * inv * bfhi(ga0.y));
        c2.x = pk2(o1[4 * g + 0] * inv * bflo(ga1.x), o1[4 * g + 1] * inv * bfhi(ga1.x)); c2.y = pk2(o1[4 * g + 2] * inv * bflo(ga1.y), o1[4 * g + 3] * inv * bfhi(ga1.y));
        *(u32x2*)(mo + 8 * g) = a; *(u32x2*)(mo + 32 + 8 * g) = c2;
    }
}

DEV void xa_stage(const bf16_t* __restrict__ src, int slot, int tid) {
#pragma unroll
    for (int i = 0; i < 4; ++i) {
        const int q = i * 256 + tid, r = q >> 5, pp = q & 31;
        __builtin_amdgcn_global_load_lds((const unsigned*)(src + r * 256 + ((pp ^ (r & 15)) << 3)), (unsigned*)(smem + slot * 16384 + q * 16), 16, 0, 0);
    }
}
DEV int perm32(int kk) { return 8 * ((kk & 15) >> 2) + 4 * (kk >> 4) + (kk & 3); }
DEV int iperm32(int pos) { return 16 * ((pos >> 2) & 1) + 4 * (pos >> 3) + (pos & 3); }
DEV void xattn_fast_unit(const Params& p, int l, int unit) {
    unsigned char* ws = p.ws;
    const int tid = otid(), lane = tid & 63, w = tid >> 6, fr = lane & 15, fq = lane >> 4;
    const int qt = unit & 31, hx = (unit >> 5) & 3, b = unit >> 7;
    const size_t tok = (size_t)b * SEQ + qt * 64 + 16 * w + fr;
    const bf16_t* kc = (const bf16_t*)(ws + OFF_KC) + (size_t)l * TMEM * D + (size_t)(b * 4 + hx) * 65536;
    const bf16_t* vct = (const bf16_t*)(ws + OFF_VCT) + (size_t)l * TMEM * D + (size_t)(b * 4 + hx) * 65536;
    const bf16_t* qp = (const bf16_t*)(ws + OFF_QC) + tok * 1024 + hx * 256 + 8 * fq;
    bf16x8 qf[8];
#pragma unroll
    for (int s2 = 0; s2 < 8; ++s2) qf[s2] = *(const bf16x8*)(qp + 32 * s2);
    const int fo = fr * 512;
    __syncthreads();
    xa_stage(kc, 0, tid);
    f32x4 sc[16];
#pragma unroll
    for (int i = 0; i < 8; ++i) {
        asm volatile("s_waitcnt vmcnt(0)" ::: "memory");
        __syncthreads();
        if (i + 1 < 8) xa_stage(kc + (size_t)(i + 1) * 8192, (i + 1) & 1, tid); else xa_stage(vct, 0, tid);
        const unsigned char* B = smem + (i & 1) * 16384 + fo;
        sc[2 * i] = (f32x4){0.f, 0.f, 0.f, 0.f}; sc[2 * i + 1] = (f32x4){0.f, 0.f, 0.f, 0.f};
#pragma unroll
        for (int s2 = 0; s2 < 8; ++s2) {
            const bf16x8 k0 = *(const bf16x8*)(B + (((4 * s2 + fq) ^ fr) << 4)), k1 = *(const bf16x8*)(B + 8192 + (((4 * s2 + fq) ^ fr) << 4));
            sc[2 * i] = MFMA16(k0, qf[s2], sc[2 * i]); sc[2 * i + 1] = MFMA16(k1, qf[s2], sc[2 * i + 1]);
        }
        __builtin_amdgcn_sched_barrier(0);
    }
    float m = sc[0][0];
#pragma unroll
    for (int i = 0; i < 16; ++i)
#pragma unroll
        for (int j = 0; j < 4; ++j) m = fmaxf(m, sc[i][j]);
    m = fmaxf(m, __shfl_xor(m, 16)); m = fmaxf(m, __shfl_xor(m, 32));
    float ls = 0.f;
#pragma unroll
    for (int i = 0; i < 16; ++i)
#pragma unroll
        for (int j = 0; j < 4; ++j) { const float e = fexp(sc[i][j] - m); sc[i][j] = e; ls += e; }
    ls += __shfl_xor(ls, 16); ls += __shfl_xor(ls, 32);
    const float inv = 1.0f / ls;
    bf16x8 pbf[8];
#pragma unroll
    for (int u = 0; u < 8; ++u) {
        u32x4 wv; wv.x = pk2(sc[2 * u][0] * inv, sc[2 * u][1] * inv); wv.y = pk2(sc[2 * u][2] * inv, sc[2 * u][3] * inv);
        wv.z = pk2(sc[2 * u + 1][0] * inv, sc[2 * u + 1][1] * inv); wv.w = pk2(sc[2 * u + 1][2] * inv, sc[2 * u + 1][3] * inv);
        pbf[u] = __builtin_bit_cast(bf16x8, wv);
    }
    bf16_t* oc = (bf16_t*)(ws + OFF_OC) + tok * 1024 + hx * 256 + 4 * fq;
#pragma unroll 1
    for (int db = 0; db < 8; ++db) {
        asm volatile("s_waitcnt vmcnt(0)" ::: "memory");
        __syncthreads();
        if (db + 1 < 8) xa_stage(vct + (size_t)(db + 1) * 8192, (db + 1) & 1, tid);
        const unsigned char* B = smem + (db & 1) * 16384 + fo;
        f32x4 oa = (f32x4){0.f, 0.f, 0.f, 0.f}, ob = (f32x4){0.f, 0.f, 0.f, 0.f};
#pragma unroll
        for (int u = 0; u < 8; ++u) {
            const bf16x8 va = *(const bf16x8*)(B + (((4 * u + fq) ^ fr) << 4)), vb = *(const bf16x8*)(B + 8192 + (((4 * u + fq) ^ fr) << 4));
            oa = MFMA16(va, pbf[u], oa); ob = MFMA16(vb, pbf[u], ob);
        }
        u32x2 o0, o1; o0.x = pk2(oa[0], oa[1]); o0.y = pk2(oa[2], oa[3]); o1.x = pk2(ob[0], ob[1]); o1.y = pk2(ob[2], ob[3]);
        *(u32x2*)(oc + db * 32) = o0; *(u32x2*)(oc + db * 32 + 16) = o1;
    }
}

DEV void router_phase(const Params& p, int l, unsigned* cnt, int* list, float* ew) {
    unsigned char* ws = p.ws;
    const int tid = otid512(), lane = tid & 63, w = tid >> 6, fr = lane & 15, fq = lane >> 4;
    const bf16_t* WR = (const bf16_t*)(ws + OFF_W + (size_t)l * W_LAYER + W_R);
    const float* brt = p.b_router + l * NRL;
    const float* rsq = (const float*)(ws + OFF_RSQ) + (size_t)(2 * l + 1) * T * 16;
    float* srl = (float*)(ws + OFF_SRL); float* ewl = (float*)(ws + OFF_EWL);
    __syncthreads();
#pragma unroll
    for (int i = 0; i < 12; ++i) { const int q = tid + 512 * i, n = q >> 7, c = q & 127; *(u32x4*)(smem_all + n * 2048 + ((c ^ (n & 15)) << 4)) = *(const u32x4*)(WR + (size_t)n * 1024 + c * 8); }
    __syncthreads();
    float* LG = (float*)(smem_all + 98304 + w * 2560);
    unsigned* lcnt = (unsigned*)(smem_all + 98304 + 8 * 2560);
    const int G8 = (int)gridDim.x * 8, npass = (T / 16 + G8 - 1) / G8;
    for (int ps = 0; ps < npass; ++ps) {
        const int g = ps * G8 + (int)gridDim.x * w + (int)blockIdx.x;
        const bool act = g < T / 16;
        if (tid < 32) lcnt[tid] = 0u;
        __syncthreads();
        int ea = 0, eb = 0; unsigned pa = 0u, pb = 0u; float w1 = 0.f, w2 = 0.f, srt = 0.f;
        if (act) {
            const int tok = g * 16 + fr;
            const bf16_t* xr = (const bf16_t*)(ws + OFF_HB) + (size_t)tok * 1024 + 8 * fq;
            const float sr = rsqrtf(ld_rsq(rsq + (size_t)tok * 16) * (1.0f / D) + EPS);
            f32x4 acc[3];
#pragma unroll
            for (int nt = 0; nt < 3; ++nt) acc[nt] = (f32x4){0.f, 0.f, 0.f, 0.f};
#pragma unroll
            for (int kb = 0; kb < 4; ++kb) {
                bf16x8 xf[8];
#pragma unroll
                for (int i = 0; i < 8; ++i) xf[i] = *(const bf16x8*)(xr + (kb * 8 + i) * 32);
#pragma unroll
                for (int i = 0; i < 8; ++i) {
                    const int c = (kb * 8 + i) * 4 + fq;
#pragma unroll
                    for (int nt = 0; nt < 3; ++nt) {
                        const bf16x8 wf = *(const bf16x8*)(smem_all + (16 * nt + fr) * 2048 + ((c ^ fr) << 4));
                        acc[nt] = MFMA16(wf, xf[i], acc[nt]);
                    }
                }
            }
#pragma unroll
            for (int nt = 0; nt < 3; ++nt)
#pragma unroll
                for (int j = 0; j < 4; ++j) { const int n = nt * 16 + 4 * fq + j; if (n < NRL) LG[fr * 40 + n] = acc[nt][j] * sr + brt[n]; }
            if (fq == 0) LG[fr * 40 + NRL] = sr;
            asm volatile("s_waitcnt lgkmcnt(0)" ::: "memory");
            if (lane < 16) {
                const float* lg = LG + lane * 40;
                int gi = 0; float gm = lg[0];
#pragma unroll
                for (int i = 1; i < 4; ++i) if (lg[i] > gm) { gm = lg[i]; gi = i; }
                float gs = 0.f;
#pragma unroll
                for (int i = 0; i < 4; ++i) gs += fexp(lg[i] - gm);
                const float gtop = 1.0f / gs;
                const float* el = lg + 4 + 8 * gi;
                int i1 = 0; float v1 = el[0];
#pragma unroll
                for (int i = 1; i < 8; ++i) if (el[i] > v1) { v1 = el[i]; i1 = i; }
                int i2 = -1; float v2 = -3.0e38f;
#pragma unroll
                for (int i = 0; i < 8; ++i) if (i != i1 && el[i] > v2) { v2 = el[i]; i2 = i; }
                const float e2 = fexp(v2 - v1), inv = 1.0f / (1.0f + e2);
                w1 = inv * gtop; w2 = e2 * inv * gtop;
                ea = gi * 8 + i1; eb = gi * 8 + i2; srt = lg[NRL];
                pa = atomicAdd(lcnt + ea, 1u); pb = atomicAdd(lcnt + eb, 1u);
            }
        }
        __syncthreads();
        if (tid < 32) { const unsigned n = lcnt[tid]; if (n) lcnt[tid] = atomicAdd(cnt + tid * 32, n); }
        __syncthreads();
        if (act && lane < 16) {
            const int tk = g * 16 + lane;
            const size_t qa = (size_t)ea * T + lcnt[ea] + pa, qb = (size_t)eb * T + lcnt[eb] + pb;
            list[qa] = tk * 2; ew[tk * 2] = w1; srl[qa] = srt; ewl[qa] = w1;
            list[qb] = tk * 2 + 1; ew[tk * 2 + 1] = w2; srl[qb] = srt; ewl[qb] = w2;
        }
        __syncthreads();
    }
}

constexpr int NPL = 13, NPH = 1 + 2 * NPL;
enum { PL_INPROJ = 0, PL_MIX, PL_SUM, PL_OUTPROJ, PL_NORM2, PL_CQ, PL_XATTN, PL_CO, PL_NORM3, PL_ROUTER, PL_GATEUP, PL_DOWN, PL_COMBINE };

struct MoeTab { int c, ts, ro, total; };
template <int SH> DEV MoeTab moe_tables(const unsigned* cnt) {
    int lane = threadIdx.x & 63; asm volatile("" : "+v"(lane));
    MoeTab t; t.c = lane < NEXP ? (int)cnt[lane * 32] : 0;
    const int nt = (t.c + (1 << SH) - 1) >> SH;
    int it = nt, ir = t.c;
#pragma unroll
    for (int d = 1; d < 32; d <<= 1) { const int a = __shfl_up(it, d), b = __shfl_up(ir, d); if (lane >= d) { it += a; ir += b; } }
    t.ts = it - nt; t.ro = ir - t.c; t.total = __shfl(it, 31);
    return t;
}
template <int SH> DEV void moe_item(const MoeTab& t, int mt, int& e, int& c, int& ro, int& m0) {
    const int lane = threadIdx.x & 63;
    const unsigned long long bal = __ballot(lane < NEXP && t.ts <= mt && mt < t.ts + ((t.c + (1 << SH) - 1) >> SH));
    e = __ffsll((long long)bal) - 1;
    c = __shfl(t.c, e); ro = __shfl(t.ro, e); m0 = (mt - __shfl(t.ts, e)) << SH;
}
DEV void moe_unit_table(const unsigned* cnt) {
    __syncthreads();
    if (threadIdx.x < 64) {
        int lane = threadIdx.x; asm volatile("" : "+v"(lane));
        const int c = lane < NEXP ? (int)cnt[lane * 32] : 0;
        const int nt = (c + 255) >> 8, rem = c - ((nt - 1) << 8), sm = (nt > 0 && rem <= 128) ? 1 : 0, nb = nt - sm;
        int pb = nb, ps = sm, pr = c;
#pragma unroll
        for (int d = 1; d < 32; d <<= 1) { const int x = __shfl_up(pb, d), y = __shfl_up(ps, d), z = __shfl_up(pr, d); if (lane >= d) { pb += x; ps += y; pr += z; } }
        const int tb = __shfl(pb, 31), ts = __shfl(ps, 31), ro = pr - c;
        int4* tab = (int4*)(smem_all + LDS_MOE);
        for (int k = 0; k < nb; ++k) tab[pb - nb + k] = make_int4(lane, c, ro, k << 8);
        if (sm) tab[tb + ps - 1] = make_int4(lane, c, ro, (nt - 1) << 8);
        if (lane == 0) *(int*)(smem_all + LDS_MOE + 160 * 16) = tb + ts;
    }
    __syncthreads();
}
template <bool GATHER_> struct MoeOrder {
    static constexpr bool GATHER = GATHER_;
    int total, G, c; const int* list;
    DEV bool next(int i, pg8::Unit& u) const {
        const int L = i * G + (((G & 7) == 0 && 4 * total - i * G >= G) ? (c & 7) * (G >> 3) + (c >> 3) : c); u.pm = 0; u.pn = L & 3; u.e = 0; u.c = 1; u.ro = 0; u.m0 = 0;
        if (L >= 4 * total) return false;
        const int4 q = ((const int4*)(smem_all + LDS_MOE))[L >> 2];
        u.e = __builtin_amdgcn_readfirstlane(q.x); u.c = __builtin_amdgcn_readfirstlane(q.y); u.ro = __builtin_amdgcn_readfirstlane(q.z); u.m0 = __builtin_amdgcn_readfirstlane(q.w);
        return true;
    }
    DEV const char* a_base(const pg8::Gemm& g, const pg8::Unit& u, size_t) const { return GATHER ? (const char*)g.A : (const char*)g.A + (size_t)(u.ro + u.m0) * g.K * 2; }
    DEV const char* b_base(const pg8::Gemm& g, const pg8::Unit& u, size_t tstep) const { return (const char*)g.Bt + (size_t)u.e * g.N * g.K * 2 + (size_t)u.pn * tstep; }
    static constexpr bool SLABS = true;
    DEV int slabs(const pg8::Unit& u) const { const int v = (u.c - u.m0 + 63) >> 6; return v < 4 ? v : 4; }
    DEV unsigned gather(const pg8::Unit& u, int row) const { int r = u.m0 + row; r = r < u.c ? r : u.c - 1; return (unsigned)(list[(size_t)u.e * T + r] >> 1); }
    DEV void a_ready(const pg8::Unit&) const {}
    DEV void done(const pg8::Unit&) const {}
};
struct Epi8GateUp {
    static constexpr bool PERM = false, AFTER_DRAIN = false;
    bf16_t* act; const float* srl;
    DEV void operator()(const f32x4 (&acc)[2][2][4][2], const pg8::Unit& u, int wr, int wc, int fr, int fq) const {
        float srv[2][4];
#pragma unroll
        for (int ai = 0; ai < 2; ++ai)
#pragma unroll
            for (int m = 0; m < 4; ++m) { const int r = u.m0 + ai * 128 + wr * 64 + m * 16 + fr; srv[ai][m] = srl[(size_t)u.e * T + (r < u.c ? r : u.c - 1)]; }
#pragma unroll
        for (int ai = 0; ai < 2; ++ai)
#pragma unroll
            for (int m = 0; m < 4; ++m) {
                const int r = u.m0 + ai * 128 + wr * 64 + m * 16 + fr;
                if (r < u.c) {
                    const float sr = srv[ai][m];
#pragma unroll
                    for (int bj = 0; bj < 2; ++bj) {
                        const f32x4 g = acc[ai][bj][m][0] * sr, up = acc[ai][bj][m][1] * sr;
                        u32x2 w; w.x = pk2(fsilu(g[0]) * up[0], fsilu(g[1]) * up[1]); w.y = pk2(fsilu(g[2]) * up[2], fsilu(g[3]) * up[3]);
                        *(u32x2*)(act + (size_t)(u.ro + r) * EFF + ((u.pn * 256 + bj * 128 + wc * 32) >> 1) + 4 * fq) = w;
                    }
                }
            }
    }
};
struct Epi8Down {
    static constexpr bool PERM = false, AFTER_DRAIN = false;
    bf16_t* yb; const int* list; const float* ewl;
    DEV void operator()(const f32x4 (&acc)[2][2][4][2], const pg8::Unit& u, int wr, int wc, int fr, int fq) const {
        int entv[2][4]; float wv[2][4];
#pragma unroll
        for (int ai = 0; ai < 2; ++ai)
#pragma unroll
            for (int m = 0; m < 4; ++m) { const int r = u.m0 + ai * 128 + wr * 64 + m * 16 + fr; const size_t q = (size_t)u.e * T + (r < u.c ? r : u.c - 1); entv[ai][m] = list[q]; wv[ai][m] = ewl[q]; }
#pragma unroll
        for (int ai = 0; ai < 2; ++ai)
#pragma unroll
            for (int m = 0; m < 4; ++m) {
                const int r = u.m0 + ai * 128 + wr * 64 + m * 16 + fr;
                if (r < u.c) {
                    const float w = wv[ai][m]; bf16_t* orow = yb + (size_t)entv[ai][m] * D + u.pn * 256 + wc * 32 + 4 * fq;
#pragma unroll
                    for (int bj = 0; bj < 2; ++bj)
#pragma unroll
                        for (int n = 0; n < 2; ++n) { const f32x4 v = acc[ai][bj][m][n] * w; u32x2 o; o.x = pk2(v[0], v[1]); o.y = pk2(v[2], v[3]); *(u32x2*)(orow + bj * 128 + n * 16) = o; }
                }
            }
    }
};
template <bool GATHER, class Epi> DEV void moe_gemm(const bf16_t* A, const bf16_t* Bt, int N, int K, const unsigned* cnt, const int* list, const Epi& E) {
    pg8::Gemm g{A, Bt, 0, N, K};
    moe_unit_table(cnt);
    MoeOrder<GATHER> S{__builtin_amdgcn_readfirstlane(*(const int*)(smem_all + LDS_MOE + 160 * 16)), (int)gridDim.x, (int)blockIdx.x, list};
    pg8::gemm_phase<Epi, MoeOrder<GATHER>, true, true>((PG8_LAS unsigned char*)smem_all, g, S, E);
}

template <class F> DEV void for_units(int n, int b0, int nb, F&& f) {
    const int rounds = (n + nb - 1) / nb;
    for (int k = 0; k < rounds; ++k) { int u = b0 + k * nb; if (u >= n) u = n - 1; f(u); }
}
#ifndef PROBE_DUP
#define PROBE_DUP 0u
#endif
#define PHASE_BEGIN(ph) if ((ph) >= ph_lo && (ph) < ph_hi) {
#define PHASE_END(ph) if ((ph) + 1 < ph_hi) xcd_barrier(bar); }
#define REPS(idx) for (int rep_ = 0; rep_ < ((((PROBE_DUP) >> (idx)) & 1u) ? 2 : 1); ++rep_)
#define ROWCTX const int tid_ = otid512(), lane = tid_ & 63, gw = blockIdx.x * 8 + (tid_ >> 6), nw = gridDim.x * 8;

__global__ void __launch_bounds__(512, 2) fwd(Params p, int ph_lo, int ph_hi) {
    unsigned char* ws = p.ws;
    const bool use_bar = (ph_hi - ph_lo) > 1;
    XcdBarrier bar; bar.bar = (unsigned*)(ws + OFF_CTL); bar.x = 0; bar.nloc = 0u; bar.nx = 0u;
    if (use_bar) bar = xcd_barrier_post((unsigned*)(ws + OFF_CTL));

    PHASE_BEGIN(0) REPS(31) phase_conv(p); PHASE_END(0)

#pragma unroll 1
    for (int l = 0; l < 2; ++l) {
        const int pb = 1 + l * NPL;
#define wl (ws + OFF_W + (size_t)l * W_LAYER)
#define HB ((bf16_t*)(ws + OFF_HB))
#define XB ((bf16_t*)(ws + OFF_X))
#define cnt ((unsigned*)(ws + OFF_CNT) + l * 1024)
#define list ((int*)(ws + OFF_LIST))
#define ew ((float*)(ws + OFF_EW))

        PHASE_BEGIN(pb + PL_INPROJ) REPS(PL_INPROJ)
        {
            Epi8InProj epi{EpiInProj{p.b_in + (size_t)l * PIN, (const float*)(ws + OFF_LBT) + l * D, ws}, (const float*)(ws + OFF_RSTD)};
            dense_gemm(XB, (const bf16_t*)(wl + W_IN), T, PIN, D, epi);
            Epi8MemKV ek{(bf16_t*)(ws + OFF_KC) + (size_t)l * TMEM * D, (bf16_t*)(ws + OFF_VCT) + (size_t)l * TMEM * D};
            if (gridDim.x == 256) {
                dense_gemm((const bf16_t*)(ws + OFF_MEMN), (const bf16_t*)(wl + W_CKV), TMEM, 2 * D, D, ek, 128, 64);
                if (blockIdx.x >= 192) conv_range(p, l, 1, CV_N1 - CV_INPROJ, CV_N1, 2 * ((int)blockIdx.x - 192) + vhalf(), 128);
            }
            else dense_gemm((const bf16_t*)(ws + OFF_MEMN), (const bf16_t*)(wl + W_CKV), TMEM, 2 * D, D, ek);
        }
        PHASE_END(pb + PL_INPROJ)

        PHASE_BEGIN(pb + PL_MIX) REPS(PL_MIX)
        {
            const int G = gridDim.x, bid = blockIdx.x, nh = G > 64 ? 64 : G;
            if (bid < nh) {
#pragma unroll 1
                for (int u = bid; u < 64; u += nh) hgrn_fused_block(p, l, u);
            }
            if (G <= 64 || bid >= 64) {
                const int b0 = G > 64 ? vbid() - 128 : vbid(), nb = G > 64 ? vgrid() - 128 : vgrid();
                if (vhalf() == 1) __syncthreads();
                for_units(2048, b0, nb, [&](int u) { swa_fast_unit(p, l, u); });
                if (vhalf() == 0) __syncthreads();
                conv_range(p, l, 1, 0, conv_mix_end(l), b0, nb);
                if (l == 0 && gridDim.x != 256) conv_layer(p, 1, 0, b0, nb);
            }
        }
        PHASE_END(pb + PL_MIX)

        PHASE_BEGIN(pb + PL_SUM) REPS(PL_SUM)
        {
            const bf16_t* MX = (const bf16_t*)(ws + OFF_MIXA); bf16_t* MS = (bf16_t*)(ws + OFF_Q1);
            ROWCTX
            for (int r0 = gw; r0 < T; r0 += 2 * nw) {
                u32x4 av[2][2], hv[2][2];
#pragma unroll
                for (int q = 0; q < 2; ++q) { const int r = r0 + q * nw < T ? r0 + q * nw : r0; const bf16_t* a = MX + (size_t)r * 2048 + 16 * lane;
                    av[q][0] = *(const u32x4*)a; av[q][1] = *(const u32x4*)(a + 8); hv[q][0] = *(const u32x4*)(a + 1024); hv[q][1] = *(const u32x4*)(a + 1032); }
#pragma unroll
                for (int q = 0; q < 2; ++q) { const int r = r0 + q * nw < T ? r0 + q * nw : r0;
                    u32x4 o0, o1;
#pragma unroll
                    for (int i = 0; i < 4; ++i) { o0[i] = pk2(bflo(av[q][0][i]) + bflo(hv[q][0][i]), bfhi(av[q][0][i]) + bfhi(hv[q][0][i])); o1[i] = pk2(bflo(av[q][1][i]) + bflo(hv[q][1][i]), bfhi(av[q][1][i]) + bfhi(hv[q][1][i])); }
                    *(u32x4*)(MS + (size_t)r * 1024 + 16 * lane) = o0; *(u32x4*)(MS + (size_t)r * 1024 + 16 * lane + 8) = o1; }
            }
        }
        PHASE_END(pb + PL_SUM)

        PHASE_BEGIN(pb + PL_OUTPROJ) REPS(PL_OUTPROJ)
        {
            Epi8Resid epi{XB, HB, (float*)(ws + OFF_RSQ) + (size_t)(2 * l) * T * 16};
            dense_gemm((const bf16_t*)(ws + OFF_Q1), (const bf16_t*)(wl + W_OUT), T, D, D, epi);
        }
        PHASE_END(pb + PL_OUTPROJ)

        PHASE_BEGIN(pb + PL_CQ) REPS(PL_CQ)
        {
            Epi8ScaleBf16 epi{(bf16_t*)(ws + OFF_QC), 0.0625f, (const float*)(ws + OFF_RSQ) + (size_t)(2 * l) * T * 16};
            dense_gemm(HB, (const bf16_t*)(wl + W_CQ), T, D, D, epi);
        }
        PHASE_END(pb + PL_CQ)

        PHASE_BEGIN(pb + PL_XATTN) REPS(PL_XATTN)
        { if (vhalf() == 1) __syncthreads(); for_units(1024, vbid(), vgrid(), [&](int u) { xattn_fast_unit(p, l, u); }); if (vhalf() == 0) __syncthreads(); }
        PHASE_END(pb + PL_XATTN)

        PHASE_BEGIN(pb + PL_CO) REPS(PL_CO)
        {
            Epi8Resid epi{HB, HB, (float*)(ws + OFF_RSQ) + (size_t)(2 * l + 1) * T * 16};
            dense_gemm((const bf16_t*)(ws + OFF_OC), (const bf16_t*)(wl + W_CO), T, D, D, epi);
        }
        PHASE_END(pb + PL_CO)

        PHASE_BEGIN(pb + PL_ROUTER) REPS(PL_ROUTER)
        { router_phase(p, l, cnt, list, ew); }
        PHASE_END(pb + PL_ROUTER)

        PHASE_BEGIN(pb + PL_GATEUP) REPS(PL_GATEUP)
        {
            Epi8GateUp epi{(bf16_t*)(ws + OFF_ACT), (const float*)(ws + OFF_SRL)};
            moe_gemm<true>(HB, (const bf16_t*)(wl + W_GU), D, D, cnt, list, epi);
            if (l == 0 && gridDim.x == 256) conv_in_moe_tail(p, 1, 0, 0, 1216);
        }
        PHASE_END(pb + PL_GATEUP)

        PHASE_BEGIN(pb + PL_DOWN) REPS(PL_DOWN)
        {
            Epi8Down epi{(bf16_t*)(ws + OFF_YB), list, (const float*)(ws + OFF_EWL)};
            moe_gemm<false>((const bf16_t*)(ws + OFF_ACT), (const bf16_t*)(wl + W_DN), D, EFF, cnt, list, epi);
            if (l == 0 && gridDim.x == 256) conv_in_moe_tail(p, 1, 1, CV_N1 - CV_INPROJ - CV_DOWN, CV_N1 - CV_INPROJ);
        }
        PHASE_END(pb + PL_DOWN)

        PHASE_BEGIN(pb + PL_COMBINE) REPS(PL_COMBINE)
        {
            const bf16_t* YB = (const bf16_t*)(ws + OFF_YB);
            const float* gn = p.final_norm;
            ROWCTX
            for (int r0 = gw; r0 < T; r0 += 2 * nw) {
                u32x2 xr[2][4], ya[2][4], yb[2][4];
#pragma unroll
                for (int q = 0; q < 2; ++q) { const int r = r0 + q * nw < T ? r0 + q * nw : r0;
#pragma unroll
                    for (int i = 0; i < 4; ++i) { const int c = 4 * lane + 256 * i;
                        xr[q][i] = *(const u32x2*)(HB + (size_t)r * D + c);
                        ya[q][i] = *(const u32x2*)(YB + (size_t)(2 * r) * D + c); yb[q][i] = *(const u32x2*)(YB + (size_t)(2 * r + 1) * D + c); } }
#pragma unroll
                for (int q = 0; q < 2; ++q) { const int r = r0 + q * nw < T ? r0 + q * nw : r0;
                    float4 v[4]; float ss = 0.f;
#pragma unroll
                    for (int i = 0; i < 4; ++i) {
                        v[i].x = (bflo(xr[q][i].x) + bflo(ya[q][i].x)) + bflo(yb[q][i].x); v[i].y = (bfhi(xr[q][i].x) + bfhi(ya[q][i].x)) + bfhi(yb[q][i].x);
                        v[i].z = (bflo(xr[q][i].y) + bflo(ya[q][i].y)) + bflo(yb[q][i].y); v[i].w = (bfhi(xr[q][i].y) + bfhi(ya[q][i].y)) + bfhi(yb[q][i].y);
                        ss += v[i].x * v[i].x + v[i].y * v[i].y + v[i].z * v[i].z + v[i].w * v[i].w;
                    }
                    ss = wave_sum(ss);
                    const float rstd = rsqrtf(ss * (1.0f / D) + EPS);
#pragma unroll
                    for (int i = 0; i < 4; ++i) {
                        const int c = 4 * lane + 256 * i;
                        if (l == 0) {
                            u32x2 o; o.x = pk2(v[i].x, v[i].y); o.y = pk2(v[i].z, v[i].w); *(u32x2*)(XB + (size_t)r * D + c) = o;
                        } else {
                            const float4 gg = *(const float4*)(gn + c);
                            float4 o; o.x = v[i].x * rstd * gg.x; o.y = v[i].y * rstd * gg.y; o.z = v[i].z * rstd * gg.z; o.w = v[i].w * rstd * gg.w;
                            *(float4*)(p.out + (size_t)r * D + c) = o;
                        }
                    }
                    if (l == 0 && lane == 0) ((float*)(ws + OFF_RSTD))[r] = rstd;
                }
            }
        }
        PHASE_END(pb + PL_COMBINE)
#undef wl
#undef HB
#undef XB
#undef cnt
#undef list
#undef ew
    }
}

extern "C" void kernel_launch(void* const* d_in, const int* in_sizes, int n_in, void* d_out, int out_size, void* d_ws, size_t ws_size, hipStream_t stream) {
    static int grid = 0;
    if (grid == 0) {
        if (n_in != 20 || ws_size < OFF_END) { fprintf(stderr, "kernel_launch: unexpected arguments (n_in %d, ws %zu, need %zu)\n", n_in, ws_size, (size_t)OFF_END); grid = -1; return; }
        int dev = 0, cus = 0, per_cu = 0;
        (void)hipGetDevice(&dev); (void)hipDeviceGetAttribute(&cus, hipDeviceAttributeMultiprocessorCount, dev);
        if (hipFuncSetAttribute((const void*)fwd, hipFuncAttributeMaxDynamicSharedMemorySize, LDS_BYTES) != hipSuccess) { fprintf(stderr, "kernel_launch: cannot raise the dynamic LDS limit\n"); grid = -1; return; }
        if (hipOccupancyMaxActiveBlocksPerMultiprocessor(&per_cu, (const void*)fwd, 512, LDS_BYTES) != hipSuccess || per_cu < 1) per_cu = 1;
        (void)hipGetLastError();
        grid = cus;
    }
    if (grid < 0) return;
    (void)hipMemsetAsync((char*)d_ws + OFF_CTL, 0, CTL_BYTES, stream);
    Params p{};
    const float** pp = (const float**)&p;
    for (int i = 0; i < 20; ++i) pp[i] = (const float*)d_in[i];
    p.out = (float*)d_out; p.ws = (unsigned char*)d_ws;
#if ONE_LAUNCH
    hipLaunchKernelGGL(fwd, dim3(grid), dim3(512), LDS_BYTES, stream, p, 0, NPH);
#else
    for (int ph = 0; ph < NPH; ++ph) hipLaunchKernelGGL(fwd, dim3(grid), dim3(512), LDS_BYTES, stream, p, ph, ph + 1);
#endif
}
```
